# Optimizing an MI355X kernel written in HIP

```python
import math
import jax, jax.numpy as jnp
from jax import lax
import numpy as np

D_MODEL = 1024
BATCH = 8
SEQ = 2048
DEPTH = 2

EPS = 1e-6
SSM_WIDTH = D_MODEL // 2
SSM_GROUP_SIZE = 16
SSM_GROUPS = SSM_WIDTH // SSM_GROUP_SIZE
SSM_STATE = 64
DT_MIN = 1e-3
DT_MAX = 1e-1
POOL_WIDTH = D_MODEL // 2
POOL_WINDOWS = (2, 4, 8, 16)
POOL_GROUPS = len(POOL_WINDOWS)
POOL_GROUP = POOL_WIDTH // POOL_GROUPS
N_IN = 2 * SSM_WIDTH + 2 * POOL_WIDTH + 2 * D_MODEL
SPLITS = (SSM_WIDTH, 2 * SSM_WIDTH, 2 * SSM_WIDTH + POOL_WIDTH,
          2 * SSM_WIDTH + 2 * POOL_WIDTH, 2 * SSM_WIDTH + 2 * POOL_WIDTH + D_MODEL)

kernel_name = "hawk_merge_s5_pool_hybrid"


def _rmsnorm(x, g):
    x32 = x.astype(jnp.float32)
    y = x32 * lax.rsqrt(jnp.mean(x32 * x32, axis=-1, keepdims=True) + EPS)
    return y.astype(x.dtype) * g


def _complex_linear_combine(left, right):
    a1r, a1i, b1r, b1i = left
    a2r, a2i, b2r, b2i = right
    ar = a2r * a1r - a2i * a1i
    ai = a2r * a1i + a2i * a1r
    br = a2r * b1r - a2i * b1i + b2r
    bi = a2r * b1i + a2i * b1r + b2i
    return ar, ai, br, bi


def _s5_branch(u, log_dt, lam_re, lam_im, b_re, b_im, c_re, c_im, d_skip, w_glu, b_glu):
    bsz, seq, _ = u.shape
    ug = u.reshape(bsz, seq, SSM_GROUPS, SSM_GROUP_SIZE)
    dt = jnp.exp(log_dt)[:, None]
    mag = jnp.exp(lam_re * dt)
    ang = lam_im * dt
    abar_re = mag * jnp.cos(ang)
    abar_im = mag * jnp.sin(ang)
    num_re = abar_re - 1.0
    num_im = abar_im
    den = lam_re * lam_re + lam_im * lam_im
    coef_re = (num_re * lam_re + num_im * lam_im) / den
    coef_im = (num_im * lam_re - num_re * lam_im) / den
    bbar_re = coef_re[..., None] * b_re - coef_im[..., None] * b_im
    bbar_im = coef_re[..., None] * b_im + coef_im[..., None] * b_re
    bu_re = jnp.einsum('blgc,gpc->blgp', ug, bbar_re)
    bu_im = jnp.einsum('blgc,gpc->blgp', ug, bbar_im)
    a_re = jnp.broadcast_to(abar_re, bu_re.shape)
    a_im = jnp.broadcast_to(abar_im, bu_im.shape)
    _, _, s_re, s_im = lax.associative_scan(_complex_linear_combine,
                                            (a_re, a_im, bu_re, bu_im), axis=1)
    y = (jnp.einsum('blgp,gcp->blgc', s_re, c_re)
         - jnp.einsum('blgp,gcp->blgc', s_im, c_im))
    y = y.reshape(bsz, seq, SSM_WIDTH) + d_skip * u
    y = jax.nn.gelu(y)
    return y * jax.nn.sigmoid(y @ w_glu + b_glu)


def _pool_branch(u, w_group, scale):
    bsz, seq, _ = u.shape
    u32 = u.astype(jnp.float32)
    cs = jnp.cumsum(u32, axis=1)
    pos = jnp.arange(seq)
    outs = []
    for gi, win in enumerate(POOL_WINDOWS):
        csg = cs[:, :, gi * POOL_GROUP:(gi + 1) * POOL_GROUP]
        shifted = jnp.pad(csg, ((0, 0), (win, 0), (0, 0)))[:, :seq]
        count = jnp.minimum(pos + 1, win).astype(jnp.float32)[None, :, None]
        mean = (csg - shifted) / count
        outs.append(mean - u32[:, :, gi * POOL_GROUP:(gi + 1) * POOL_GROUP])
    pooled = jnp.stack(outs, axis=2).astype(u.dtype)
    mixed = jnp.einsum('blgc,gcd->blgd', pooled, w_group).reshape(bsz, seq, POOL_WIDTH)
    return mixed * scale


def setup_inputs(seed: int = 0) -> dict:
    key = jax.random.key(seed)
    ks = jax.random.split(key, 24)
    f32 = jnp.float32
    nrm = lambda k, shape, std: (jax.random.normal(k, shape, f32) * std)
    x = jax.random.normal(ks[0], (BATCH, SEQ, D_MODEL), f32)
    norm_g = 1.0 + nrm(ks[1], (DEPTH, D_MODEL), 0.05)
    w_in = nrm(ks[2], (DEPTH, D_MODEL, N_IN), D_MODEL ** -0.5)
    b_in = nrm(ks[3], (DEPTH, N_IN), 0.02)
    ssm_log_dt = jax.random.uniform(ks[4], (DEPTH, SSM_GROUPS), f32,
                                    math.log(DT_MIN), math.log(DT_MAX))
    n_idx = jnp.arange(SSM_STATE, dtype=f32)
    ssm_lam_re = -0.5 + nrm(ks[5], (DEPTH, SSM_GROUPS, SSM_STATE), 0.01)
    ssm_lam_im = math.pi * n_idx[None, None, :] + nrm(ks[6], (DEPTH, SSM_GROUPS, SSM_STATE), 0.01)
    b_std = (2.0 * SSM_GROUP_SIZE) ** -0.5
    ssm_b_re = nrm(ks[7], (DEPTH, SSM_GROUPS, SSM_STATE, SSM_GROUP_SIZE), b_std)
    ssm_b_im = nrm(ks[8], (DEPTH, SSM_GROUPS, SSM_STATE, SSM_GROUP_SIZE), b_std)
    c_std = SSM_STATE ** -0.5
    ssm_c_re = nrm(ks[9], (DEPTH, SSM_GROUPS, SSM_GROUP_SIZE, SSM_STATE), c_std)
    ssm_c_im = nrm(ks[10], (DEPTH, SSM_GROUPS, SSM_GROUP_SIZE, SSM_STATE), c_std)
    ssm_d = nrm(ks[11], (DEPTH, SSM_WIDTH), 1.0)
    ssm_w_glu = nrm(ks[12], (DEPTH, SSM_WIDTH, SSM_WIDTH), SSM_WIDTH ** -0.5)
    ssm_b_glu = nrm(ks[13], (DEPTH, SSM_WIDTH), 0.02)
    pool_w = nrm(ks[14], (DEPTH, POOL_GROUPS, POOL_GROUP, POOL_GROUP), POOL_GROUP ** -0.5)
    pool_scale = 1.0 + nrm(ks[15], (DEPTH, POOL_WIDTH), 0.1)
    w_branch_a = nrm(ks[16], (DEPTH, SSM_WIDTH, D_MODEL), SSM_WIDTH ** -0.5)
    w_branch_b = nrm(ks[17], (DEPTH, POOL_WIDTH, D_MODEL), POOL_WIDTH ** -0.5)
    w_out = nrm(ks[18], (DEPTH, D_MODEL, D_MODEL), D_MODEL ** -0.5)
    final_norm_g = 1.0 + nrm(ks[19], (D_MODEL,), 0.05)
    return {"x": x, "norm_g": norm_g, "w_in": w_in, "b_in": b_in,
            "ssm_log_dt": ssm_log_dt, "ssm_lam_re": ssm_lam_re, "ssm_lam_im": ssm_lam_im,
            "ssm_b_re": ssm_b_re, "ssm_b_im": ssm_b_im, "ssm_c_re": ssm_c_re, "ssm_c_im": ssm_c_im,
            "ssm_d": ssm_d, "ssm_w_glu": ssm_w_glu, "ssm_b_glu": ssm_b_glu,
            "pool_w": pool_w, "pool_scale": pool_scale,
            "w_branch_a": w_branch_a, "w_branch_b": w_branch_b, "w_out": w_out,
            "final_norm_g": final_norm_g}


def reference(x, norm_g, w_in, b_in, ssm_log_dt, ssm_lam_re, ssm_lam_im, ssm_b_re, ssm_b_im,
              ssm_c_re, ssm_c_im, ssm_d, ssm_w_glu, ssm_b_glu, pool_w, pool_scale,
              w_branch_a, w_branch_b, w_out, final_norm_g):
    for l in range(DEPTH):
        h = _rmsnorm(x, norm_g[l])
        proj = h @ w_in[l] + b_in[l]
        ua, za, ub, zb, ga, gb = jnp.split(proj, SPLITS, axis=-1)
        ya = _s5_branch(ua, ssm_log_dt[l], ssm_lam_re[l], ssm_lam_im[l], ssm_b_re[l], ssm_b_im[l],
                        ssm_c_re[l], ssm_c_im[l], ssm_d[l], ssm_w_glu[l], ssm_b_glu[l])
        ya = ya * jax.nn.silu(za)
        yb = _pool_branch(ub, pool_w[l], pool_scale[l]) * jax.nn.silu(zb)
        merged = (jax.nn.sigmoid(ga) * (ya @ w_branch_a[l])
                  + jax.nn.sigmoid(gb) * (yb @ w_branch_b[l]))
        x = x + merged @ w_out[l]
    return _rmsnorm(x, final_norm_g)
```

```cpp
#include <hip/hip_runtime.h>
#include <stdint.h>
#include <cstdio>

#ifndef N_LAUNCH_MODE
#define N_LAUNCH_MODE 0
#endif

typedef unsigned short bf16_t;
typedef short bf16x8 __attribute__((ext_vector_type(8)));
typedef float f32x4 __attribute__((ext_vector_type(4)));
typedef unsigned u32x4 __attribute__((ext_vector_type(4)));
typedef unsigned u32x2 __attribute__((ext_vector_type(2)));
#define LAS __attribute__((address_space(3)))

constexpr int T = 16384, DM = 1024, SEQ = 2048;
constexpr int KA = 640;
constexpr float EPS = 1e-6f;

constexpr size_t OFF_BAR = 0;
constexpr size_t OFF_SS = 16384;
constexpr size_t OFF_AQ = OFF_SS + 3 * (size_t)T * 4;
constexpr size_t OFF_W = 262144;
constexpr size_t WL_WIN = 0, WL_WGLU = WL_WIN + 4096 * 1024 * 2, WL_POOL = WL_WGLU + 512 * 512 * 2, WL_WA = WL_POOL + 4 * 128 * 128 * 2,
                 WL_WB = WL_WA + 1024 * 512 * 2, WL_WOUT = WL_WB + 1024 * 512 * 2, WL_M13 = WL_WOUT + 1024 * 1024 * 2,
                 WL_M2 = WL_M13 + (size_t)32 * 512 * KA * 2, WL_SIZE = WL_M2 + (size_t)32 * 128 * 512 * 2;
constexpr size_t OFF_H = OFF_W + 2 * WL_SIZE;
constexpr size_t OFF_YB = OFF_H, OFF_S = OFF_H + (size_t)T * 512 * 2;
constexpr size_t OFF_UAP = OFF_H + (size_t)T * 1024 * 2;
constexpr size_t OFF_YA = OFF_UAP;
constexpr size_t OFF_ZA = OFF_UAP + (size_t)32 * 512 * KA * 2;
constexpr size_t OFF_UB = OFF_ZA + (size_t)T * 512 * 2;
constexpr size_t OFF_YPRE = OFF_UB;
constexpr size_t OFF_ZB = OFF_UB + (size_t)T * 512 * 2;
constexpr size_t OFF_GA = OFF_ZB + (size_t)T * 512 * 2;
constexpr size_t OFF_GB = OFF_GA + (size_t)T * 1024 * 2;
constexpr size_t WS_END = OFF_GB + (size_t)T * 1024 * 2;
constexpr int LDS_BYTES = 66560;
constexpr int LDS_XB = 66544;

struct Params {
    const float *x, *norm_g, *w_in, *b_in, *log_dt, *lam_re, *lam_im, *b_re, *b_im, *c_re, *c_im, *d_skip, *w_glu, *b_glu, *pool_w, *pool_scale, *w_a, *w_b, *w_out, *final_g;
    float* out; unsigned char* ws;
    int ph_lo, ph_hi;
};

__device__ __forceinline__ unsigned pk2(float lo, float hi) { unsigned r; asm("v_cvt_pk_bf16_f32 %0, %1, %2" : "=v"(r) : "v"(lo), "v"(hi)); return r; }
__device__ __forceinline__ float bf_lo(unsigned u) { return __uint_as_float(u << 16); }
__device__ __forceinline__ float bf_hi(unsigned u) { return __uint_as_float(u & 0xffff0000u); }
__device__ __forceinline__ float sigm(float x) { return __builtin_amdgcn_rcpf(1.f + __expf(-x)); }
__device__ __forceinline__ float silu(float x) { return x * sigm(x); }
__device__ __forceinline__ float gelu_tanh(float y) { return y * sigm(1.5957691216f * (y + 0.044715f * y * y * y)); }
__device__ __forceinline__ u32x2 pk4(f32x4 v) { u32x2 r; r.x = pk2(v.x, v.y); r.y = pk2(v.z, v.w); return r; }
__device__ __forceinline__ f32x4 unpk4(u32x2 u) { f32x4 r; r.x = bf_lo(u.x); r.y = bf_hi(u.x); r.z = bf_lo(u.y); r.w = bf_hi(u.y); return r; }

#define XB_TMO      128
#define XB_XCNT(j)  (256  + 64 * (j))
#define XB_XSUB(j)  (1280 + 64 * (j))
#define XB_XGEN(j)  (2304 + 64 * (j))
#define XB_TOP      3328
#define XB_TOPGEN   3392
#define XCD_BAR_WORDS 3456
#define XB_SPIN_CAP (1u << 20)
__device__ __forceinline__ unsigned xb_ld(unsigned* p)              { return __hip_atomic_load(p, __ATOMIC_RELAXED, __HIP_MEMORY_SCOPE_AGENT); }
__device__ __forceinline__ unsigned xb_add(unsigned* p, unsigned v) { return __hip_atomic_fetch_add(p, v, __ATOMIC_RELAXED, __HIP_MEMORY_SCOPE_AGENT); }
__device__ __forceinline__ unsigned xb_xcc_id() { return (unsigned)__builtin_amdgcn_s_getreg((3 << 11) | 20) & 0xFu; }
#define XB_SPIN(cond, bar) do { unsigned _sp = 0; while (cond) { __builtin_amdgcn_s_sleep(1); \
    if ((++_sp & 255u) == 0u) { if (xb_ld(&(bar)[XB_TMO])) break; if (_sp > XB_SPIN_CAP) { atomicAdd(&(bar)[XB_TMO], 1u); break; } } } } while (0)
struct XcdBarrier { unsigned* bar; unsigned x; volatile LAS unsigned* st; };
__device__ __forceinline__ XcdBarrier xcd_barrier_post(unsigned* bar, volatile LAS unsigned* st) {
    XcdBarrier b; b.bar = bar; b.x = xb_xcc_id(); b.st = st;
    if (threadIdx.x == 0) (void)xb_add(&bar[XB_XCNT(b.x)], 1u);
    return b;
}
__device__ __forceinline__ void xcd_barrier_complete(unsigned* bar, unsigned x, unsigned& nloc, unsigned& nx) {
    const unsigned G = gridDim.x * gridDim.y * gridDim.z;
    unsigned sum, cnt, mine, sp = 0u;
    for (;;) {
        sum = 0u; cnt = 0u; mine = 0u;
#pragma unroll
        for (unsigned j = 0; j < 16; ++j) { const unsigned c = xb_ld(&bar[XB_XCNT(j)]); sum += c; cnt += (c > 0u) ? 1u : 0u; mine = (j == x) ? c : mine; }
        if (sum == G) break;
        __builtin_amdgcn_s_sleep(1);
        if ((++sp & 255u) == 0u) { if (xb_ld(&bar[XB_TMO])) break; if (sp > XB_SPIN_CAP) { atomicAdd(&bar[XB_TMO], 1u); break; } }
    }
    nloc = mine > 0u ? mine : 1u; nx = cnt > 0u ? cnt : 1u;
}
__device__ __forceinline__ void xcd_barrier(const XcdBarrier& b) {
    asm volatile("s_waitcnt vmcnt(0)" ::: "memory");
    __syncthreads();
    if (threadIdx.x == 0) {
        unsigned* bar = b.bar;
        __builtin_amdgcn_s_waitcnt(0);
        unsigned nloc = b.st[0], nx = b.st[1];
        if (nloc == 0u) { xcd_barrier_complete(bar, b.x, nloc, nx); b.st[0] = nloc; b.st[1] = nx; }
        const unsigned old = xb_add(&bar[XB_XSUB(b.x)], 1u);
        const unsigned gen = old / nloc;
        if (old + 1u == (gen + 1u) * nloc) {
            __builtin_amdgcn_fence(__ATOMIC_RELEASE, "agent");
            asm volatile("s_waitcnt vmcnt(0)" ::: "memory");
            const unsigned og = xb_add(&bar[XB_TOP], 1u);
            const unsigned tg = og / nx;
            if (og + 1u == (tg + 1u) * nx) xb_add(&bar[XB_TOPGEN], 1u);
            else XB_SPIN(xb_ld(&bar[XB_TOPGEN]) == tg, bar);
            __builtin_amdgcn_fence(__ATOMIC_ACQUIRE, "agent");
            xb_add(&bar[XB_XGEN(b.x)], 1u);
            asm volatile("s_waitcnt vmcnt(0)" ::: "memory");
        } else {
            XB_SPIN(xb_ld(&bar[XB_XGEN(b.x)]) == gen, bar);
            __builtin_amdgcn_fence(__ATOMIC_ACQUIRE, "agent");
            asm volatile("s_waitcnt vmcnt(0)" ::: "memory");
        }
    }
    __syncthreads();
}

struct LoadPlain { const bf16_t* base; int ld;
    __device__ __forceinline__ bf16x8 operator()(int r, int kc) const { return *(const bf16x8*)(base + (size_t)r * ld + kc * 8); } };
struct LoadRemap { const bf16_t* base; int ld; int nk1;
    __device__ __forceinline__ bf16x8 operator()(int r, int kc) const { int kt = kc >> 3; if (kt >= nk1) kt += 8 - nk1; return *(const bf16x8*)(base + (size_t)r * ld + kt * 64 + (kc & 7) * 8); } };
struct LoadPool { const bf16_t* ub; int row0; int pg;
    __device__ __forceinline__ bf16x8 operator()(int r, int kc) const {
        const int t = row0 + r, pos = t & (SEQ - 1), win = 2 << pg, cnt = (pos + 1) < win ? (pos + 1) : win;
        const bf16_t* p = ub + (size_t)t * 512 + pg * 128 + kc * 8;
        const u32x4 c = *(const u32x4*)p;
        float s0 = bf_lo(c.x), s1 = bf_hi(c.x), s2 = bf_lo(c.y), s3 = bf_hi(c.y), s4 = bf_lo(c.z), s5 = bf_hi(c.z), s6 = bf_lo(c.w), s7 = bf_hi(c.w);
        const float c0 = s0, c1 = s1, c2 = s2, c3 = s3, c4 = s4, c5 = s5, c6 = s6, c7 = s7;
        for (int j = 1; j < cnt; ++j) { const u32x4 v = *(const u32x4*)(p - (size_t)j * 512);
            s0 += bf_lo(v.x); s1 += bf_hi(v.x); s2 += bf_lo(v.y); s3 += bf_hi(v.y); s4 += bf_lo(v.z); s5 += bf_hi(v.z); s6 += bf_lo(v.w); s7 += bf_hi(v.w); }
        const float ic = 1.f / (float)cnt;
        u32x4 o; o.x = pk2(s0 * ic - c0, s1 * ic - c1); o.y = pk2(s2 * ic - c2, s3 * ic - c3); o.z = pk2(s4 * ic - c4, s5 * ic - c5); o.w = pk2(s6 * ic - c6, s7 * ic - c7);
        return __builtin_bit_cast(bf16x8, o);
    } };

template <class AL, class BL>
__device__ __forceinline__ void gemm_mainloop(f32x4 (&acc)[4][4], const AL& al, const BL& bl, const int nkt, unsigned char* lds) {
    int tid = threadIdx.x; asm volatile("" : "+v"(tid));
    const int lane = tid & 63, wid = tid >> 6, wr = wid >> 1, wc = wid & 1;
    const int lr = tid >> 3, lc = tid & 7;
    const int st_off = lr * 128 + ((lc ^ (lr & 7)) << 4);
    const int fr = lane & 15, fq = lane >> 4;
    const int rd_a = (wr * 64 + fr) * 128, rd_b = 16384 + (wc * 64 + fr) * 128;
    const int sw0 = ((fq ^ (fr & 7)) << 4), sw1 = (((4 + fq) ^ (fr & 7)) << 4);
    bf16x8 ra[4], rb[4];
#pragma unroll
    for (int i = 0; i < 4; ++i) { ra[i] = al(lr + 32 * i, lc); rb[i] = bl(lr + 32 * i, lc); }
#pragma unroll
    for (int i = 0; i < 4; ++i) { *(bf16x8*)(lds + st_off + i * 4096) = ra[i]; *(bf16x8*)(lds + 16384 + st_off + i * 4096) = rb[i]; }
    __syncthreads();
#pragma unroll 1
    for (int kt = 0; kt < nkt; ++kt) {
        unsigned char* cur = lds + (kt & 1) * 32768;
        const bool more = (kt + 1) < nkt;
        if (more) {
#pragma unroll
            for (int i = 0; i < 4; ++i) { ra[i] = al(lr + 32 * i, (kt + 1) * 8 + lc); rb[i] = bl(lr + 32 * i, (kt + 1) * 8 + lc); }
        }
#pragma unroll
        for (int s = 0; s < 2; ++s) {
            const int sw = s ? sw1 : sw0;
            bf16x8 af[4], bf[4];
#pragma unroll
            for (int i = 0; i < 4; ++i) af[i] = *(const bf16x8*)(cur + rd_a + i * 2048 + sw);
#pragma unroll
            for (int j = 0; j < 4; ++j) bf[j] = *(const bf16x8*)(cur + rd_b + j * 2048 + sw);
#pragma unroll
            for (int i = 0; i < 4; ++i)
#pragma unroll
                for (int j = 0; j < 4; ++j) acc[i][j] = __builtin_amdgcn_mfma_f32_16x16x32_bf16(bf[j], af[i], acc[i][j], 0, 0, 0);
        }
        if (more) {
            unsigned char* nxt = lds + ((kt + 1) & 1) * 32768;
#pragma unroll
            for (int i = 0; i < 4; ++i) { *(bf16x8*)(nxt + st_off + i * 4096) = ra[i]; *(bf16x8*)(nxt + 16384 + st_off + i * 4096) = rb[i]; }
        }
        __syncthreads();
    }
}
__device__ __forceinline__ void zero_acc(f32x4 (&acc)[4][4]) {
#pragma unroll
    for (int i = 0; i < 4; ++i)
#pragma unroll
        for (int j = 0; j < 4; ++j) acc[i][j] = (f32x4){0.f, 0.f, 0.f, 0.f};
}
#define EPI_LOOP(...) do { int _t = threadIdx.x; asm volatile("" : "+v"(_t)); const int _l = _t & 63, _w = _t >> 6, _wr = _w >> 1, _wc = _w & 1, _fr = _l & 15, _fq = _l >> 4; \
    _Pragma("unroll") for (int i = 0; i < 4; ++i) _Pragma("unroll") for (int j = 0; j < 4; ++j) { const int m = _wr * 64 + i * 16 + _fr, n = _wc * 64 + j * 16 + _fq * 4; f32x4& v = acc[i][j]; __VA_ARGS__ } } while (0)

__device__ __forceinline__ void transpose_tile(const float* __restrict__ src, int K, int N, bf16_t* __restrict__ dst, int kb, int nb, float* tile) {
    const int tid = threadIdx.x, k0 = kb * 64, n0 = nb * 64;
#pragma unroll
    for (int i = 0; i < 4; ++i) { const int k = (tid >> 4) + 16 * i, n4 = (tid & 15) * 4;
        const f32x4 v = *(const f32x4*)(src + (size_t)(k0 + k) * N + n0 + n4);
        tile[k * 65 + n4] = v.x; tile[k * 65 + n4 + 1] = v.y; tile[k * 65 + n4 + 2] = v.z; tile[k * 65 + n4 + 3] = v.w; }
    __syncthreads();
#pragma unroll
    for (int i = 0; i < 2; ++i) { const int n = (tid >> 3) + 32 * i, kc = (tid & 7) * 8; const float* s = tile + kc * 65 + n;
        u32x4 o; o.x = pk2(s[0], s[65]); o.y = pk2(s[2 * 65], s[3 * 65]); o.z = pk2(s[4 * 65], s[5 * 65]); o.w = pk2(s[6 * 65], s[7 * 65]);
        *(u32x4*)(dst + (size_t)(n0 + n) * K + k0 + kc) = o; }
    __syncthreads();
}
__device__ __forceinline__ void ssm_tables_item(const Params& P, int item, unsigned char* lds) {
    const int tid = threadIdx.x, l = item >> 7, g = (item >> 2) & 31, tq = item & 3, lg = l * 32 + g;
    float* pwr = (float*)lds;
    float* pwi = pwr + 33 * 64;
    float* bbr = pwi + 33 * 64;
    float* bbi = bbr + 1024;
    float* ccr = bbi + 1024;
    float* cci = ccr + 1024;
    float* ktab = cci + 1024;
    unsigned char* wl = P.ws + OFF_W + (size_t)l * WL_SIZE;
    bf16_t* M13 = (bf16_t*)(wl + WL_M13) + (size_t)g * 512 * KA;
    bf16_t* M2 = (bf16_t*)(wl + WL_M2) + (size_t)g * 128 * 512;
    if (tid < 64) {
        const int p = tid;
        const double dt = exp((double)P.log_dt[lg]);
        const double lr = (double)P.lam_re[lg * 64 + p], li = (double)P.lam_im[lg * 64 + p];
        const double mag = exp(lr * dt), ang = li * dt;
        const double ar = mag * cos(ang), ai = mag * sin(ang);
        const double nr = ar - 1.0, ni = ai, den = lr * lr + li * li;
        const double cr = (nr * lr + ni * li) / den, ci = (ni * lr - nr * li) / den;
        double pr = 1.0, pi = 0.0;
        for (int k = 0; k <= 32; ++k) { pwr[k * 64 + p] = (float)pr; pwi[k * 64 + p] = (float)pi; const double t = pr * ar - pi * ai; pi = pr * ai + pi * ar; pr = t; }
        for (int c = 0; c < 16; ++c) { const double br = (double)P.b_re[(size_t)(lg * 64 + p) * 16 + c], bi = (double)P.b_im[(size_t)(lg * 64 + p) * 16 + c];
            bbr[p * 16 + c] = (float)(cr * br - ci * bi); bbi[p * 16 + c] = (float)(cr * bi + ci * br); }
    }
    for (int i = tid; i < 1024; i += 256) { ccr[i] = P.c_re[(size_t)lg * 1024 + i]; cci[i] = P.c_im[(size_t)lg * 1024 + i]; }
    __syncthreads();
    {
        const int co = tid >> 4, ci = tid & 15;
        float a[32];
#pragma unroll
        for (int k = 0; k < 32; ++k) a[k] = 0.f;
        for (int p = 0; p < 64; ++p) {
            const float xr = ccr[co * 64 + p], xi = cci[co * 64 + p], yr = bbr[p * 16 + ci], yi = bbi[p * 16 + ci];
            const float cbr = xr * yr - xi * yi, cbi = xr * yi + xi * yr;
#pragma unroll
            for (int k = 0; k < 32; ++k) a[k] += cbr * pwr[k * 64 + p] - cbi * pwi[k * 64 + p];
        }
#pragma unroll
        for (int k = 0; k < 32; ++k) ktab[k * 256 + tid] = a[k];
    }
    __syncthreads();
    for (int idx = tid; idx < 128 * 64; idx += 256) {
        const int nl = idx >> 6, kc = idx & 63, t = tq * 8 + (nl >> 4), co = nl & 15, s = kc >> 1, ci0 = (kc & 1) * 8, lag = t - s;
        u32x4 o = {0u, 0u, 0u, 0u};
        if (lag >= 0) { const float* kp = ktab + lag * 256 + co * 16 + ci0; o.x = pk2(kp[0], kp[1]); o.y = pk2(kp[2], kp[3]); o.z = pk2(kp[4], kp[5]); o.w = pk2(kp[6], kp[7]); }
        *(u32x4*)(M13 + (size_t)(t * 16 + co) * KA + kc * 8) = o;
    }
    for (int idx = tid; idx < 128 * 16; idx += 256) {
        const int nl = idx >> 4, pc = idx & 15, t = tq * 8 + (nl >> 4), co = nl & 15;
        float vv[8];
#pragma unroll
        for (int pp = 0; pp < 4; ++pp) { const int p = pc * 4 + pp; const float cr = ccr[co * 64 + p], ci = cci[co * 64 + p], wr = pwr[(t + 1) * 64 + p], wi = pwi[(t + 1) * 64 + p];
            vv[2 * pp] = cr * wr - ci * wi; vv[2 * pp + 1] = -(cr * wi + ci * wr); }
        u32x4 o; o.x = pk2(vv[0], vv[1]); o.y = pk2(vv[2], vv[3]); o.z = pk2(vv[4], vv[5]); o.w = pk2(vv[6], vv[7]);
        *(u32x4*)(M13 + (size_t)(t * 16 + co) * KA + 512 + pc * 8) = o;
    }
    for (int idx = tid; idx < 32 * 64; idx += 256) {
        const int n2 = tq * 32 + (idx >> 6), kc = idx & 63, p = n2 >> 1, ri = n2 & 1, s = kc >> 1, ci0 = (kc & 1) * 8;
        const float wr = pwr[(31 - s) * 64 + p], wi = pwi[(31 - s) * 64 + p];
        float vv[8];
#pragma unroll
        for (int j = 0; j < 8; ++j) { const float br = bbr[p * 16 + ci0 + j], bi = bbi[p * 16 + ci0 + j]; vv[j] = ri ? (wr * bi + wi * br) : (wr * br - wi * bi); }
        u32x4 o; o.x = pk2(vv[0], vv[1]); o.y = pk2(vv[2], vv[3]); o.z = pk2(vv[4], vv[5]); o.w = pk2(vv[6], vv[7]);
        *(u32x4*)(M2 + (size_t)n2 * 512 + kc * 8) = o;
    }
    if (tq == 0 && tid < 64) { float* aq = (float*)(P.ws + OFF_AQ) + (size_t)(lg * 64 + tid) * 2; aq[0] = pwr[32 * 64 + tid]; aq[1] = pwi[32 * 64 + tid]; }
    __syncthreads();
}
__device__ __forceinline__ void phase_prologue(const Params& P, unsigned char* lds) {
    const int tid = threadIdx.x, G = gridDim.x;
    constexpr int I_IN = 16 * 64, I_GLU = 64, I_POOL = 16, I_A = 128, I_B = 128, I_OUT = 256, I_L = I_IN + I_GLU + I_POOL + I_A + I_B + I_OUT;
    for (int it = blockIdx.x; it < 2 * I_L; it += G) {
        const int l = it / I_L; int r = it % I_L;
        unsigned char* wl = P.ws + OFF_W + (size_t)l * WL_SIZE;
        float* tile = (float*)lds;
        if (r < I_IN) { transpose_tile(P.w_in + (size_t)l * 1024 * 4096, 1024, 4096, (bf16_t*)(wl + WL_WIN), r / 64, r % 64, tile); continue; } r -= I_IN;
        if (r < I_GLU) { transpose_tile(P.w_glu + (size_t)l * 512 * 512, 512, 512, (bf16_t*)(wl + WL_WGLU), r / 8, r % 8, tile); continue; } r -= I_GLU;
        if (r < I_POOL) { const int pg = r >> 2; transpose_tile(P.pool_w + (size_t)(l * 4 + pg) * 128 * 128, 128, 128, (bf16_t*)(wl + WL_POOL) + pg * 128 * 128, (r >> 1) & 1, r & 1, tile); continue; } r -= I_POOL;
        if (r < I_A) { transpose_tile(P.w_a + (size_t)l * 512 * 1024, 512, 1024, (bf16_t*)(wl + WL_WA), r / 16, r % 16, tile); continue; } r -= I_A;
        if (r < I_B) { transpose_tile(P.w_b + (size_t)l * 512 * 1024, 512, 1024, (bf16_t*)(wl + WL_WB), r / 16, r % 16, tile); continue; } r -= I_B;
        transpose_tile(P.w_out + (size_t)l * 1024 * 1024, 1024, 1024, (bf16_t*)(wl + WL_WOUT), r / 16, r % 16, tile);
    }
    for (int it = blockIdx.x; it < 256; it += G) ssm_tables_item(P, it, lds);
    float* ss = (float*)(P.ws + OFF_SS);
    for (int i = blockIdx.x * 256 + tid; i < 2 * T; i += G * 256) ss[T + i] = 0.f;
    bf16_t* H = (bf16_t*)(P.ws + OFF_H);
    const int lane = tid & 63, wid = tid >> 6;
    for (int it = blockIdx.x; it < T / 4; it += G) {
        const int row = it * 4 + wid;
        const float* xr = P.x + (size_t)row * DM;
        float s = 0.f;
#pragma unroll
        for (int j = 0; j < 4; ++j) { const int c = lane * 4 + 256 * j; const f32x4 v = *(const f32x4*)(xr + c); const f32x4 gg = *(const f32x4*)(P.norm_g + c);
            s += (v.x * v.x + v.y * v.y) + (v.z * v.z + v.w * v.w);
            *(u32x2*)(H + (size_t)row * DM + c) = pk4(v * gg); }
#pragma unroll
        for (int o = 1; o < 64; o <<= 1) s += __shfl_xor(s, o);
        if (lane == 0) ss[row] = s;
    }
}

__device__ __forceinline__ void phase_proj(const Params& P, int l, unsigned char* lds) {
    const unsigned char* wl = P.ws + OFF_W + (size_t)l * WL_SIZE;
    const bf16_t* H = (const bf16_t*)(P.ws + OFF_H); const bf16_t* W = (const bf16_t*)(wl + WL_WIN);
    const float* ss = (const float*)(P.ws + OFF_SS) + (size_t)l * T; const float* bias = P.b_in + (size_t)l * 4096;
    for (int t = blockIdx.x; t < 128 * 32; t += gridDim.x) {
        const int nt = t & 31, mt = t >> 5;
        f32x4 acc[4][4]; zero_acc(acc);
        gemm_mainloop(acc, LoadPlain{H + (size_t)mt * 128 * DM, DM}, LoadPlain{W + (size_t)nt * 128 * DM, DM}, 16, lds);
        bf16_t* dst; int ldd, cbase;
        if (nt < 4) { dst = (bf16_t*)(P.ws + OFF_UAP); ldd = 0; cbase = 0; }
        else if (nt < 8) { dst = (bf16_t*)(P.ws + OFF_ZA); ldd = 512; cbase = 512; }
        else if (nt < 12) { dst = (bf16_t*)(P.ws + OFF_UB); ldd = 512; cbase = 1024; }
        else if (nt < 16) { dst = (bf16_t*)(P.ws + OFF_ZB); ldd = 512; cbase = 1536; }
        else if (nt < 24) { dst = (bf16_t*)(P.ws + OFF_GA); ldd = 1024; cbase = 2048; }
        else { dst = (bf16_t*)(P.ws + OFF_GB); ldd = 1024; cbase = 3072; }
        EPI_LOOP(
            const int row = mt * 128 + m, col = nt * 128 + n;
            const float inv = rsqrtf(ss[row] * (1.f / DM) + EPS);
            const f32x4 o = v * inv + *(const f32x4*)(bias + col);
            if (nt < 4) { const int g = col >> 4, cc = col & 15; *(u32x2*)(dst + ((size_t)(g * 512 + (row >> 5)) * KA + (row & 31) * 16 + cc)) = pk4(o); }
            else *(u32x2*)(dst + (size_t)row * ldd + (col - cbase)) = pk4(o);
        );
    }
}
__device__ __forceinline__ void phase_state_pool(const Params& P, int l, unsigned char* lds) {
    const unsigned char* wl = P.ws + OFF_W + (size_t)l * WL_SIZE;
    for (int t = blockIdx.x; t < 128 + 512; t += gridDim.x) {
        f32x4 acc[4][4]; zero_acc(acc);
        if (t < 128) {
            const int g = t >> 2, mt = t & 3;
            gemm_mainloop(acc, LoadPlain{(const bf16_t*)(P.ws + OFF_UAP) + (size_t)(g * 512 + mt * 128) * KA, KA}, LoadPlain{(const bf16_t*)(wl + WL_M2) + (size_t)g * 128 * 512, 512}, 8, lds);
            float* S = (float*)(P.ws + OFF_S) + (size_t)(g * 512 + mt * 128) * 128;
            EPI_LOOP( *(f32x4*)(S + (size_t)m * 128 + n) = v; );
        } else {
            const int u = t - 128, pg = u & 3, mt = u >> 2;
            gemm_mainloop(acc, LoadPool{(const bf16_t*)(P.ws + OFF_UB), mt * 128, pg}, LoadPlain{(const bf16_t*)(wl + WL_POOL) + (size_t)pg * 128 * 128, 128}, 2, lds);
            const bf16_t* ZB = (const bf16_t*)(P.ws + OFF_ZB); bf16_t* YB = (bf16_t*)(P.ws + OFF_YB); const float* sc = P.pool_scale + (size_t)l * 512;
            EPI_LOOP(
                const int row = mt * 128 + m, col = pg * 128 + n;
                const f32x4 z = unpk4(*(const u32x2*)(ZB + (size_t)row * 512 + col)); const f32x4 s4 = *(const f32x4*)(sc + col);
                f32x4 o; o.x = v.x * s4.x * silu(z.x); o.y = v.y * s4.y * silu(z.y); o.z = v.z * s4.z * silu(z.z); o.w = v.w * s4.w * silu(z.w);
                *(u32x2*)(YB + (size_t)row * 512 + col) = pk4(o);
            );
        }
    }
}
__device__ __forceinline__ void phase_carry(const Params& P, int l) {
    const float* S = (const float*)(P.ws + OFF_S); bf16_t* U = (bf16_t*)(P.ws + OFF_UAP);
    for (int idx = blockIdx.x * 256 + threadIdx.x; idx < 32 * 8 * 64; idx += gridDim.x * 256) {
        const int p = idx & 63, b = (idx >> 6) & 7, g = idx >> 9;
        const float* aq = (const float*)(P.ws + OFF_AQ) + (size_t)((l * 32 + g) * 64 + p) * 2;
        const float ar = aq[0], ai = aq[1];
        float xr = 0.f, xi = 0.f;
#pragma unroll 8
        for (int c = 0; c < 64; ++c) {
            const size_t m = (size_t)g * 512 + b * 64 + c;
            *(unsigned*)(U + m * KA + 512 + 2 * p) = pk2(xr, xi);
            const float sr = S[m * 128 + 2 * p], si = S[m * 128 + 2 * p + 1];
            const float nr = ar * xr - ai * xi + sr; xi = ar * xi + ai * xr + si; xr = nr;
        }
    }
}
__device__ __forceinline__ void phase_y(const Params& P, int l, unsigned char* lds) {
    const unsigned char* wl = P.ws + OFF_W + (size_t)l * WL_SIZE;
    const bf16_t* U = (const bf16_t*)(P.ws + OFF_UAP); const float* dsk = P.d_skip + (size_t)l * 512; bf16_t* YP = (bf16_t*)(P.ws + OFF_YPRE);
    for (int t = blockIdx.x; t < 512; t += gridDim.x) {
        const int nt = 3 - (t >> 7), g = (t >> 2) & 31, mt = t & 3;
        const int nk1 = (nt + 1) * 2;
        f32x4 acc[4][4]; zero_acc(acc);
        gemm_mainloop(acc, LoadRemap{U + (size_t)(g * 512 + mt * 128) * KA, KA, nk1}, LoadRemap{(const bf16_t*)(wl + WL_M13) + (size_t)(g * 512 + nt * 128) * KA, KA, nk1}, nk1 + 2, lds);
        EPI_LOOP(
            const int mm = mt * 128 + m, nn = nt * 128 + n, ch = g * 16 + (nn & 15);
            const f32x4 u = unpk4(*(const u32x2*)(U + (size_t)(g * 512 + mm) * KA + nn)); const f32x4 d4 = *(const f32x4*)(dsk + ch);
            f32x4 o; o.x = gelu_tanh(v.x + d4.x * u.x); o.y = gelu_tanh(v.y + d4.y * u.y); o.z = gelu_tanh(v.z + d4.z * u.z); o.w = gelu_tanh(v.w + d4.w * u.w);
            *(u32x2*)(YP + (size_t)(mm * 32 + (nn >> 4)) * 512 + ch) = pk4(o);
        );
    }
}
__device__ __forceinline__ void phase_glu(const Params& P, int l, unsigned char* lds) {
    const unsigned char* wl = P.ws + OFF_W + (size_t)l * WL_SIZE;
    const bf16_t* YP = (const bf16_t*)(P.ws + OFF_YPRE); const bf16_t* ZA = (const bf16_t*)(P.ws + OFF_ZA); bf16_t* YA = (bf16_t*)(P.ws + OFF_YA); const float* bg = P.b_glu + (size_t)l * 512;
    for (int t = blockIdx.x; t < 512; t += gridDim.x) {
        const int nt = t & 3, mt = t >> 2;
        f32x4 acc[4][4]; zero_acc(acc);
        gemm_mainloop(acc, LoadPlain{YP + (size_t)mt * 128 * 512, 512}, LoadPlain{(const bf16_t*)(wl + WL_WGLU) + (size_t)nt * 128 * 512, 512}, 8, lds);
        EPI_LOOP(
            const int row = mt * 128 + m, col = nt * 128 + n;
            const f32x4 y = unpk4(*(const u32x2*)(YP + (size_t)row * 512 + col)); const f32x4 z = unpk4(*(const u32x2*)(ZA + (size_t)row * 512 + col)); const f32x4 b4 = *(const f32x4*)(bg + col);
            f32x4 o; o.x = y.x * sigm(v.x + b4.x) * silu(z.x); o.y = y.y * sigm(v.y + b4.y) * silu(z.y); o.z = y.z * sigm(v.z + b4.z) * silu(z.z); o.w = y.w * sigm(v.w + b4.w) * silu(z.w);
            *(u32x2*)(YA + (size_t)row * 512 + col) = pk4(o);
        );
    }
}
__device__ __forceinline__ void phase_merge(const Params& P, int l, unsigned char* lds) {
    const unsigned char* wl = P.ws + OFF_W + (size_t)l * WL_SIZE;
    const bf16_t* YA = (const bf16_t*)(P.ws + OFF_YA); const bf16_t* YB = (const bf16_t*)(P.ws + OFF_YB);
    bf16_t* GA = (bf16_t*)(P.ws + OFF_GA); const bf16_t* GB = (const bf16_t*)(P.ws + OFF_GB);
    for (int t = blockIdx.x; t < 1024; t += gridDim.x) {
        const int nt = t & 7, mt = t >> 3;
        f32x4 acc[4][4]; zero_acc(acc);
        gemm_mainloop(acc, LoadPlain{YA + (size_t)mt * 128 * 512, 512}, LoadPlain{(const bf16_t*)(wl + WL_WA) + (size_t)nt * 128 * 512, 512}, 8, lds);
        u32x2 part[4][4];
        EPI_LOOP(
            const int row = mt * 128 + m, col = nt * 128 + n;
            const f32x4 ga = unpk4(*(const u32x2*)(GA + (size_t)row * DM + col));
            f32x4 o; o.x = v.x * sigm(ga.x); o.y = v.y * sigm(ga.y); o.z = v.z * sigm(ga.z); o.w = v.w * sigm(ga.w);
            part[i][j] = pk4(o);
        );
        zero_acc(acc);
        gemm_mainloop(acc, LoadPlain{YB + (size_t)mt * 128 * 512, 512}, LoadPlain{(const bf16_t*)(wl + WL_WB) + (size_t)nt * 128 * 512, 512}, 8, lds);
        EPI_LOOP(
            const int row = mt * 128 + m, col = nt * 128 + n;
            const f32x4 gb = unpk4(*(const u32x2*)(GB + (size_t)row * DM + col)); const f32x4 w = unpk4(part[i][j]);
            f32x4 o; o.x = w.x + sigm(gb.x) * v.x; o.y = w.y + sigm(gb.y) * v.y; o.z = w.z + sigm(gb.z) * v.z; o.w = w.w + sigm(gb.w) * v.w;
            *(u32x2*)(GA + (size_t)row * DM + col) = pk4(o);
        );
    }
}
__device__ __forceinline__ void phase_out(const Params& P, int l, unsigned char* lds) {
    const unsigned char* wl = P.ws + OFF_W + (size_t)l * WL_SIZE;
    const bf16_t* MG = (const bf16_t*)(P.ws + OFF_GA); const float* xin = l == 0 ? P.x : P.out; float* xout = P.out;
    float* ssn = (float*)(P.ws + OFF_SS) + (size_t)(l + 1) * T; bf16_t* H = (bf16_t*)(P.ws + OFF_H); const float* gn = P.norm_g + (size_t)(l + 1) * DM;
    for (int t = blockIdx.x; t < 1024; t += gridDim.x) {
        const int nt = t & 7, mt = t >> 3;
        f32x4 acc[4][4]; zero_acc(acc);
        gemm_mainloop(acc, LoadPlain{MG + (size_t)mt * 128 * DM, DM}, LoadPlain{(const bf16_t*)(wl + WL_WOUT) + (size_t)nt * 128 * DM, DM}, 16, lds);
        const int lane = threadIdx.x & 63, w = threadIdx.x >> 6, wr = w >> 1, wc = w & 1, fr = lane & 15, fq = lane >> 4;
#pragma unroll
        for (int i = 0; i < 4; ++i) {
            const int row = mt * 128 + wr * 64 + i * 16 + fr;
            float s = 0.f;
#pragma unroll
            for (int j = 0; j < 4; ++j) {
                const int col = nt * 128 + wc * 64 + j * 16 + fq * 4;
                const f32x4 o = *(const f32x4*)(xin + (size_t)row * DM + col) + acc[i][j];
                *(f32x4*)(xout + (size_t)row * DM + col) = o;
                s += (o.x * o.x + o.y * o.y) + (o.z * o.z + o.w * o.w);
                if (l == 0) *(u32x2*)(H + (size_t)row * DM + col) = pk4(o * *(const f32x4*)(gn + col));
            }
            s += __shfl_xor(s, 16); s += __shfl_xor(s, 32);
            if (fq == 0) atomicAdd(ssn + row, s);
        }
    }
}
__device__ __forceinline__ void phase_final(const Params& P) {
    const float* ss = (const float*)(P.ws + OFF_SS) + 2 * (size_t)T;
    for (int i = blockIdx.x * 256 + threadIdx.x; i < T * (DM / 4); i += gridDim.x * 256) {
        const int row = i >> 8, c = (i & 255) * 4;
        const float inv = rsqrtf(ss[row] * (1.f / DM) + EPS);
        f32x4* p = (f32x4*)(P.out + (size_t)row * DM + c);
        *p = (*p * inv) * *(const f32x4*)(P.final_g + c);
    }
}

constexpr int N_PHASES = 16;
__global__ void __launch_bounds__(256, 2) hawk_fwd(Params P) {
    extern __shared__ __attribute__((aligned(16))) unsigned char lds[];
    volatile LAS unsigned* st = (volatile LAS unsigned*)(LAS unsigned char*)(lds + LDS_XB);
    const bool multi = (P.ph_hi - P.ph_lo) > 1;
    XcdBarrier xb; xb.bar = (unsigned*)(P.ws + OFF_BAR); xb.x = 0; xb.st = st;
    if (multi) {
        if (threadIdx.x == 0) { st[0] = 0u; st[1] = 0u; st[2] = 0u; st[3] = 0u; }
        __syncthreads();
        xb = xcd_barrier_post((unsigned*)(P.ws + OFF_BAR), st);
    }
    for (int ph = P.ph_lo; ph < P.ph_hi; ++ph) {
        if (ph > P.ph_lo) xcd_barrier(xb);
#ifndef DBG_MASK
#define DBG_MASK 0x1ff
#endif
        if (ph == 0) { if (DBG_MASK & 1) phase_prologue(P, lds); }
        else if (ph == 15) { if (DBG_MASK & 2) phase_final(P); }
        else {
            const int l = (ph - 1) / 7, q = (ph - 1) % 7;
            if (q == 0) { if (DBG_MASK & 4) phase_proj(P, l, lds); }
            else if (q == 1) { if (DBG_MASK & 8) phase_state_pool(P, l, lds); }
            else if (q == 2) { if (DBG_MASK & 16) phase_carry(P, l); }
            else if (q == 3) { if (DBG_MASK & 32) phase_y(P, l, lds); }
            else if (q == 4) { if (DBG_MASK & 64) phase_glu(P, l, lds); }
            else if (q == 5) { if (DBG_MASK & 128) phase_merge(P, l, lds); }
            else { if (DBG_MASK & 256) phase_out(P, l, lds); }
        }
    }
}

extern "C" void kernel_launch(void* const* d_in, const int* in_sizes, int n_in, void* d_out, int out_size, void* d_ws, size_t ws_size, hipStream_t stream) {
    static int grid = 0;
    if (grid == 0) {
        if (n_in != 20 || in_sizes[0] != T * DM || out_size != T * DM || ws_size < WS_END) { fprintf(stderr, "kernel_launch: unexpected shapes / workspace (%zu needed, %zu given)\n", (size_t)WS_END, ws_size); grid = -1; return; }
        int dev = 0, cus = 0, per_cu = 0;
        if (hipGetDevice(&dev) != hipSuccess || hipDeviceGetAttribute(&cus, hipDeviceAttributeMultiprocessorCount, dev) != hipSuccess) { grid = -1; return; }
        if (hipFuncSetAttribute((const void*)hawk_fwd, hipFuncAttributeMaxDynamicSharedMemorySize, LDS_BYTES) != hipSuccess) { fprintf(stderr, "kernel_launch: hipFuncSetAttribute failed\n"); grid = -1; return; }
        if (hipOccupancyMaxActiveBlocksPerMultiprocessor(&per_cu, (const void*)hawk_fwd, 256, LDS_BYTES) != hipSuccess || per_cu < 1) { fprintf(stderr, "kernel_launch: occupancy query failed\n"); (void)hipGetLastError(); per_cu = 1; }
        if (per_cu > 2) per_cu = 2;
        grid = cus * per_cu;
    }
    if (grid < 0) return;
    (void)hipMemsetAsync((unsigned char*)d_ws + OFF_BAR, 0, 16384, stream);
    Params p{};
    const float** pp = (const float**)&p;
    for (int i = 0; i < 20; ++i) pp[i] = (const float*)d_in[i];
    p.out = (float*)d_out; p.ws = (unsigned char*)d_ws;
#if N_LAUNCH_MODE == 1
    p.ph_lo = 0; p.ph_hi = N_PHASES;
    hipLaunchKernelGGL(hawk_fwd, dim3(grid), dim3(256), LDS_BYTES, stream, p);
#else
    for (int ph = 0; ph < N_PHASES; ++ph) { p.ph_lo = ph; p.ph_hi = ph + 1; hipLaunchKernelGGL(hawk_fwd, dim3(grid), dim3(256), LDS_BYTES, stream, p); }
#endif
}
```

```cpp
#include <hip/hip_runtime.h>
#include <stdint.h>
#include <cstdio>

#ifndef N_LAUNCH_MODE
#define N_LAUNCH_MODE 1
#endif

typedef unsigned short bf16_t;
typedef short bf16x8 __attribute__((ext_vector_type(8)));
typedef float f32x4 __attribute__((ext_vector_type(4)));
typedef unsigned u32x4 __attribute__((ext_vector_type(4)));
typedef unsigned u32x2 __attribute__((ext_vector_type(2)));
#define LAS __attribute__((address_space(3)))

constexpr int T = 16384, DM = 1024, SEQ = 2048;
constexpr int QC = 16, QSH = 4;
constexpr int KI = QC * 16;
constexpr int KA = KI + 128;
constexpr int MG = T / QC;
constexpr int KTI = KI / 64;
constexpr float EPS = 1e-6f;

constexpr size_t OFF_BAR = 0;
constexpr size_t OFF_SS = 32768;
constexpr size_t OFF_AQ = OFF_SS + 3 * (size_t)T * 4;
constexpr size_t OFF_W = 262144;
constexpr size_t WL_WIN = 0, WL_WGLU = WL_WIN + 4096 * 1024 * 2, WL_POOL = WL_WGLU + 512 * 512 * 2, WL_WA = WL_POOL + 4 * 128 * 128 * 2,
                 WL_WB = WL_WA + 1024 * 512 * 2, WL_WOUT = WL_WB + 1024 * 512 * 2, WL_M13 = WL_WOUT + 1024 * 1024 * 2,
                 WL_M2 = WL_M13 + (size_t)32 * KI * KA * 2, WL_SIZE = WL_M2 + (size_t)32 * 128 * KI * 2;
constexpr size_t OFF_H = OFF_W + 2 * WL_SIZE;
constexpr size_t OFF_S = OFF_H + (size_t)T * 512 * 2;
constexpr size_t OFF_UAP = OFF_H + (size_t)T * 1024 * 2;

constexpr size_t OFF_ZA = OFF_UAP + (size_t)32 * MG * KA * 2;
constexpr size_t OFF_UB = OFF_ZA + (size_t)T * 512 * 2;

constexpr size_t OFF_ZB = OFF_UB + (size_t)T * 512 * 2;
constexpr size_t OFF_GA = OFF_ZB + (size_t)T * 512 * 2;
constexpr size_t OFF_GB = OFF_GA + (size_t)T * 1024 * 2;
constexpr size_t OFF_YA = OFF_ZA;
constexpr size_t OFF_YB = OFF_GB + (size_t)T * 1024 * 2;
constexpr size_t OFF_YPRE = OFF_YB + (size_t)T * 512 * 2;
constexpr size_t WS_END = OFF_YPRE + (size_t)T * 512 * 2;
constexpr int HALF_LDS = 67584;
constexpr int LDS_BYTES = 2 * HALF_LDS + 1024;
constexpr int LDS_XB = 2 * HALF_LDS;
constexpr int NTHR = 512;

struct Params {
    const float *x, *norm_g, *w_in, *b_in, *log_dt, *lam_re, *lam_im, *b_re, *b_im, *c_re, *c_im, *d_skip, *w_glu, *b_glu, *pool_w, *pool_scale, *w_a, *w_b, *w_out, *final_g;
    float* out; unsigned char* ws;
    int ph_lo, ph_hi;
};

__device__ __forceinline__ unsigned pk2(float lo, float hi) { unsigned r; asm("v_cvt_pk_bf16_f32 %0, %1, %2" : "=v"(r) : "v"(lo), "v"(hi)); return r; }
__device__ __forceinline__ float bf_lo(unsigned u) { return __uint_as_float(u << 16); }
__device__ __forceinline__ float bf_hi(unsigned u) { return __uint_as_float(u & 0xffff0000u); }
__device__ __forceinline__ float sigm(float x) { return __builtin_amdgcn_rcpf(1.f + __expf(-x)); }
__device__ __forceinline__ float silu(float x) { return x * sigm(x); }
__device__ __forceinline__ float gelu_tanh(float y) { return y * sigm(1.5957691216f * (y + 0.044715f * y * y * y)); }
__device__ __forceinline__ u32x2 pk4(f32x4 v) { u32x2 r; r.x = pk2(v.x, v.y); r.y = pk2(v.z, v.w); return r; }
__device__ __forceinline__ f32x4 unpk4(u32x2 u) { f32x4 r; r.x = bf_lo(u.x); r.y = bf_hi(u.x); r.z = bf_lo(u.y); r.w = bf_hi(u.y); return r; }
__device__ __forceinline__ u32x4 pk8(f32x4 a, f32x4 b) { u32x4 w; w.x = pk2(a.x, a.y); w.y = pk2(a.z, a.w); w.z = pk2(b.x, b.y); w.w = pk2(b.z, b.w); return w; }
__device__ __forceinline__ void unpk8(u32x4 w, f32x4& a, f32x4& b) { a.x = bf_lo(w.x); a.y = bf_hi(w.x); a.z = bf_lo(w.y); a.w = bf_hi(w.y); b.x = bf_lo(w.z); b.y = bf_hi(w.z); b.z = bf_lo(w.w); b.w = bf_hi(w.w); }

#define XB_TMO      128
#define XB_XCNT(j)  (256  + 64 * (j))
#define XB_XSUB(j)  (1280 + 64 * (j))
#define XB_XGEN(j)  (2304 + 64 * (j))
#define XB_TOP      3328
#define XB_TOPGEN   3392
#define XCD_BAR_WORDS 3456
#define XB_SPIN_CAP (1u << 20)
__device__ __forceinline__ unsigned xb_ld(unsigned* p)              { return __hip_atomic_load(p, __ATOMIC_RELAXED, __HIP_MEMORY_SCOPE_AGENT); }
__device__ __forceinline__ unsigned xb_add(unsigned* p, unsigned v) { return __hip_atomic_fetch_add(p, v, __ATOMIC_RELAXED, __HIP_MEMORY_SCOPE_AGENT); }
__device__ __forceinline__ unsigned xb_xcc_id() { return (unsigned)__builtin_amdgcn_s_getreg((3 << 11) | 20) & 0xFu; }
#define XB_SPIN(cond, bar) do { unsigned _sp = 0; while (cond) { __builtin_amdgcn_s_sleep(1); \
    if ((++_sp & 255u) == 0u) { if (xb_ld(&(bar)[XB_TMO])) break; if (_sp > XB_SPIN_CAP) { atomicAdd(&(bar)[XB_TMO], 1u); break; } } } } while (0)
struct XcdBarrier { unsigned* bar; unsigned x; volatile LAS unsigned* st; };
__device__ __forceinline__ XcdBarrier xcd_barrier_post(unsigned* bar, volatile LAS unsigned* st) {
    XcdBarrier b; b.bar = bar; b.x = xb_xcc_id(); b.st = st;
    if (threadIdx.x == 0) st[2] = xb_add(&bar[XB_XCNT(b.x)], 1u);
    return b;
}
__device__ __forceinline__ void xcd_barrier_complete(unsigned* bar, unsigned x, unsigned& nloc, unsigned& nx) {
    const unsigned G = gridDim.x * gridDim.y * gridDim.z;
    unsigned sum, cnt, mine, sp = 0u;
    for (;;) {
        sum = 0u; cnt = 0u; mine = 0u;
#pragma unroll
        for (unsigned j = 0; j < 16; ++j) { const unsigned c = xb_ld(&bar[XB_XCNT(j)]); sum += c; cnt += (c > 0u) ? 1u : 0u; mine = (j == x) ? c : mine; }
        if (sum == G) break;
        __builtin_amdgcn_s_sleep(1);
        if ((++sp & 255u) == 0u) { if (xb_ld(&bar[XB_TMO])) break; if (sp > XB_SPIN_CAP) { atomicAdd(&bar[XB_TMO], 1u); break; } }
    }
    nloc = mine > 0u ? mine : 1u; nx = cnt > 0u ? cnt : 1u;
}
__device__ __forceinline__ void xcd_barrier(const XcdBarrier& b) {
    asm volatile("s_waitcnt vmcnt(0)" ::: "memory");
    __syncthreads();
    if (threadIdx.x == 0) {
        unsigned* bar = b.bar;
        __builtin_amdgcn_s_waitcnt(0);
        unsigned nloc = b.st[0], nx = b.st[1];
        if (nloc == 0u) { xcd_barrier_complete(bar, b.x, nloc, nx); b.st[0] = nloc; b.st[1] = nx; }
        const unsigned old = xb_add(&bar[XB_XSUB(b.x)], 1u);
        const unsigned gen = old / nloc;
        if (old + 1u == (gen + 1u) * nloc) {
            __builtin_amdgcn_fence(__ATOMIC_RELEASE, "agent");
            asm volatile("s_waitcnt vmcnt(0)" ::: "memory");
            const unsigned og = xb_add(&bar[XB_TOP], 1u);
            const unsigned tg = og / nx;
            if (og + 1u == (tg + 1u) * nx) xb_add(&bar[XB_TOPGEN], 1u);
            else XB_SPIN(xb_ld(&bar[XB_TOPGEN]) == tg, bar);
            __builtin_amdgcn_fence(__ATOMIC_ACQUIRE, "agent");
            xb_add(&bar[XB_XGEN(b.x)], 1u);
            asm volatile("s_waitcnt vmcnt(0)" ::: "memory");
        } else {
            XB_SPIN(xb_ld(&bar[XB_XGEN(b.x)]) == gen, bar);
            __builtin_amdgcn_fence(__ATOMIC_ACQUIRE, "agent");
            asm volatile("s_waitcnt vmcnt(0)" ::: "memory");
        }
    }
    __syncthreads();
}

__device__ __forceinline__ void group_barrier(const XcdBarrier& b, unsigned* grp, unsigned n = 4u, int slot = 3) {
    asm volatile("s_waitcnt vmcnt(0)" ::: "memory");
    __syncthreads();
    if (threadIdx.x == 0) {
        __builtin_amdgcn_s_waitcnt(0);
        const unsigned k = b.st[slot] + 1u; b.st[slot] = k;
        (void)xb_add(grp, 1u);
        const unsigned target = n * k;
        XB_SPIN(xb_ld(grp) < target, b.bar);
        __builtin_amdgcn_fence(__ATOMIC_ACQUIRE, "agent");
        asm volatile("s_waitcnt vmcnt(0)" ::: "memory");
    }
    __syncthreads();
}
__device__ __forceinline__ void group_arrive(const XcdBarrier& b, unsigned* grp, int slot) {
    asm volatile("s_waitcnt vmcnt(0)" ::: "memory");
    __syncthreads();
    if (threadIdx.x == 0) { b.st[slot] = b.st[slot] + 1u; (void)xb_add(grp, 1u); }
    __syncthreads();
}
__device__ __forceinline__ void seam_sync(const XcdBarrier& b, unsigned* grp, bool local) { if (local) group_barrier(b, grp); else xcd_barrier(b); }
__device__ __forceinline__ void seam_sync_xcc(const XcdBarrier& b, unsigned* xcnt, bool local) { if (local) group_barrier(b, xcnt, 32u, 4); else xcd_barrier(b); }

struct LoadPlain { const bf16_t* base; int ld;
    __device__ __forceinline__ bf16x8 operator()(int r, int kc) const { return *(const bf16x8*)(base + (size_t)r * ld + kc * 8); } };
struct LoadRemap { const bf16_t* base; int ld; int nk1;
    __device__ __forceinline__ bf16x8 operator()(int r, int kc) const { int kt = kc >> 3; if (kt >= nk1) kt += KTI - nk1; return *(const bf16x8*)(base + (size_t)r * ld + kt * 64 + (kc & 7) * 8); } };
struct LoadPool { const bf16_t* ub; int row0; int pg;
    __device__ __forceinline__ bf16x8 operator()(int r, int kc) const {
        const int t = row0 + r, pos = t & (SEQ - 1), win = 2 << pg, cnt = (pos + 1) < win ? (pos + 1) : win;
        const bf16_t* p = ub + (size_t)t * 512 + pg * 128 + kc * 8;
        const u32x4 c = *(const u32x4*)p;
        float s0 = bf_lo(c.x), s1 = bf_hi(c.x), s2 = bf_lo(c.y), s3 = bf_hi(c.y), s4 = bf_lo(c.z), s5 = bf_hi(c.z), s6 = bf_lo(c.w), s7 = bf_hi(c.w);
        const float c0 = s0, c1 = s1, c2 = s2, c3 = s3, c4 = s4, c5 = s5, c6 = s6, c7 = s7;
        for (int j = 1; j < cnt; ++j) { const u32x4 v = *(const u32x4*)(p - (size_t)j * 512);
            s0 += bf_lo(v.x); s1 += bf_hi(v.x); s2 += bf_lo(v.y); s3 += bf_hi(v.y); s4 += bf_lo(v.z); s5 += bf_hi(v.z); s6 += bf_lo(v.w); s7 += bf_hi(v.w); }
        const float ic = 1.f / (float)cnt;
        u32x4 o; o.x = pk2(s0 * ic - c0, s1 * ic - c1); o.y = pk2(s2 * ic - c2, s3 * ic - c3); o.z = pk2(s4 * ic - c4, s5 * ic - c5); o.w = pk2(s6 * ic - c6, s7 * ic - c7);
        return __builtin_bit_cast(bf16x8, o);
    } };

__device__ __forceinline__ void mma_ktile(f32x4 (&acc)[4][4], const unsigned char* cur, int tid) {
    const int lane = tid & 63, wid = tid >> 6, wr = wid >> 1, wc = wid & 1, fr = lane & 15, fq = lane >> 4;
    const int rd_a = (wr * 64 + fr) * 128, rd_b = 16384 + (wc * 64 + fr) * 128;
    const int sw0 = ((fq ^ (fr & 7)) << 4), sw1 = (((4 + fq) ^ (fr & 7)) << 4);
#pragma unroll
    for (int s = 0; s < 2; ++s) {
        const int sw = s ? sw1 : sw0;
        bf16x8 af[4], bf[4];
#pragma unroll
        for (int i = 0; i < 4; ++i) af[i] = *(const bf16x8*)(cur + rd_a + i * 2048 + sw);
#pragma unroll
        for (int j = 0; j < 4; ++j) bf[j] = *(const bf16x8*)(cur + rd_b + j * 2048 + sw);
        __builtin_amdgcn_s_setprio(1);
#pragma unroll
        for (int i = 0; i < 4; ++i)
#pragma unroll
            for (int j = 0; j < 4; ++j) acc[i][j] = __builtin_amdgcn_mfma_f32_16x16x32_bf16(bf[j], af[i], acc[i][j], 0, 0, 0);
        __builtin_amdgcn_s_setprio(0);
    }
}
template <class AL, class BL>
__device__ __forceinline__ void gemm_mainloop(f32x4 (&acc)[4][4], const AL& al, const BL& bl, const int nkt, unsigned char* lds) {
    int tid = threadIdx.x & 255; asm volatile("" : "+v"(tid));
    const int lr = tid >> 3, lc = tid & 7;
    const int st_off = lr * 128 + ((lc ^ (lr & 7)) << 4);
    bf16x8 a0[4], b0[4], a1[4], b1[4], a2[4], b2[4];
#define GM_LOAD(A, B, KT) do { _Pragma("unroll") for (int i = 0; i < 4; ++i) { A[i] = al(lr + 32 * i, (KT) * 8 + lc); B[i] = bl(lr + 32 * i, (KT) * 8 + lc); } } while (0)
#define GM_STORE(A, B, BUF) do { _Pragma("unroll") for (int i = 0; i < 4; ++i) { *(bf16x8*)((BUF) + st_off + i * 4096) = A[i]; *(bf16x8*)((BUF) + 16384 + st_off + i * 4096) = B[i]; } } while (0)
#define GM_STEP(KT, LA, LB, SA, SB) do { const int _kt = (KT); if (_kt < nkt) { \
        if (_kt + 3 < nkt) GM_LOAD(LA, LB, _kt + 3); \
        mma_ktile(acc, lds + (_kt & 1) * 32768, tid); \
        if (_kt + 1 < nkt) GM_STORE(SA, SB, lds + ((_kt + 1) & 1) * 32768); \
        __syncthreads(); } } while (0)
    GM_LOAD(a0, b0, 0);
    if (nkt > 1) GM_LOAD(a1, b1, 1);
    if (nkt > 2) GM_LOAD(a2, b2, 2);
    GM_STORE(a0, b0, lds);
    __syncthreads();
#pragma unroll 1
    for (int kt = 0; kt < nkt; kt += 3) {
        GM_STEP(kt, a0, b0, a1, b1);
        GM_STEP(kt + 1, a1, b1, a2, b2);
        GM_STEP(kt + 2, a2, b2, a0, b0);
    }
#undef GM_LOAD
#undef GM_STORE
#undef GM_STEP
}
__device__ __forceinline__ void zero_acc(f32x4 (&acc)[4][4]) {
#pragma unroll
    for (int i = 0; i < 4; ++i)
#pragma unroll
        for (int j = 0; j < 4; ++j) acc[i][j] = (f32x4){0.f, 0.f, 0.f, 0.f};
}
#define EPI_LOOP(...) do { int _t = threadIdx.x & 255; asm volatile("" : "+v"(_t)); const int _l = _t & 63, _w = _t >> 6, _wr = _w >> 1, _wc = _w & 1, _fr = _l & 15, _fq = _l >> 4; \
    _Pragma("unroll") for (int i = 0; i < 4; ++i) _Pragma("unroll") for (int j = 0; j < 4; ++j) { const int m = _wr * 64 + i * 16 + _fr, n = _wc * 64 + j * 16 + _fq * 4; f32x4& v = acc[i][j]; __VA_ARGS__ } } while (0)


#define ADD8(S, V, SGN) do { S[0] += SGN bf_lo(V.x); S[1] += SGN bf_hi(V.x); S[2] += SGN bf_lo(V.y); S[3] += SGN bf_hi(V.y); S[4] += SGN bf_lo(V.z); S[5] += SGN bf_hi(V.z); S[6] += SGN bf_lo(V.w); S[7] += SGN bf_hi(V.w); } while (0)
__device__ __forceinline__ void pool_tile(f32x4 (&acc)[4][4], const bf16_t* UB, const bf16_t* Wt, const bf16_t* ZB, u32x2 (&zz)[4][4], int row0, int pg, unsigned char* lds) {
    int tid = threadIdx.x & 255; asm volatile("" : "+v"(tid));
    const int c16 = tid & 15, r0 = (tid >> 4) * 8, kt = c16 >> 3, lc = c16 & 7;
    const int t0 = row0 + r0, pos0 = t0 & (SEQ - 1), win = 2 << pg;
    const bf16_t* p = UB + (size_t)t0 * 512 + pg * 128 + c16 * 8;
    float s[8];
#pragma unroll
    for (int e = 0; e < 8; ++e) s[e] = 0.f;
#define GLD16(dst, ptr) asm volatile("global_load_dwordx4 %0, %1, off" : "=v"(dst) : "v"(ptr) : "memory")
#define GLD8(dst, ptr) asm volatile("global_load_dwordx2 %0, %1, off" : "=v"(dst) : "v"(ptr) : "memory")
#define PIN4(a, b, c, d) asm volatile("" : "+v"(a), "+v"(b), "+v"(c), "+v"(d) :: "memory")
    u32x4 wv[8], pre[15], cur[8], old[8];
#pragma unroll
    for (int i = 0; i < 8; ++i) { const bf16_t* q = Wt + (size_t)((tid >> 4) + 16 * i) * 128 + c16 * 8; GLD16(wv[i], q); }
#pragma unroll
    for (int j = 1; j < 16; ++j) { const bool ok = (j < win) && (pos0 >= j); const bf16_t* q = p - (size_t)(ok ? j : 0) * 512; GLD16(pre[j - 1], q); }
#pragma unroll
    for (int i = 0; i < 8; ++i) { const bf16_t* q = p + (size_t)i * 512; GLD16(cur[i], q);
        const int jo = i - win + 1; const bool ok = (pos0 + jo >= 0); const bf16_t* q2 = p + (long)(ok ? jo : 0) * 512; GLD16(old[i], q2); }
    asm volatile("s_waitcnt vmcnt(0)" : "+v"(pre[0]), "+v"(pre[1]), "+v"(pre[2]), "+v"(pre[3]) :: "memory");
    PIN4(pre[4], pre[5], pre[6], pre[7]); PIN4(pre[8], pre[9], pre[10], pre[11]); PIN4(pre[12], pre[13], pre[14], cur[0]);
    PIN4(cur[1], cur[2], cur[3], cur[4]); PIN4(cur[5], cur[6], cur[7], old[0]); PIN4(old[1], old[2], old[3], old[4]); PIN4(old[5], old[6], old[7], wv[0]);
    PIN4(wv[1], wv[2], wv[3], wv[4]); PIN4(wv[5], wv[6], wv[7], wv[0]);
#pragma unroll
    for (int j = 1; j < 16; ++j) { const bool ok = (j < win) && (pos0 >= j); if (!ok) pre[j - 1] = (u32x4){0u, 0u, 0u, 0u}; }
#pragma unroll
    for (int i = 0; i < 8; ++i) { const bool ok = (pos0 + i - win + 1 >= 0); if (!ok) old[i] = (u32x4){0u, 0u, 0u, 0u}; }
#pragma unroll
    for (int j = 0; j < 15; ++j) ADD8(s, pre[j], +);
#pragma unroll
    for (int i = 0; i < 8; ++i) {
        const u32x4 c = cur[i]; ADD8(s, c, +);
        const int pos = pos0 + i, cnt = (pos + 1) < win ? (pos + 1) : win; const float ic = 1.f / (float)cnt;
        u32x4 o; o.x = pk2(s[0] * ic - bf_lo(c.x), s[1] * ic - bf_hi(c.x)); o.y = pk2(s[2] * ic - bf_lo(c.y), s[3] * ic - bf_hi(c.y));
        o.z = pk2(s[4] * ic - bf_lo(c.z), s[5] * ic - bf_hi(c.z)); o.w = pk2(s[6] * ic - bf_lo(c.w), s[7] * ic - bf_hi(c.w));
        const int r = r0 + i;
        *(u32x4*)(lds + kt * 32768 + r * 128 + ((lc ^ (r & 7)) << 4)) = o;
        ADD8(s, old[i], -);
    }
#pragma unroll
    for (int i = 0; i < 8; ++i) { const int r = (tid >> 4) + 16 * i; *(u32x4*)(lds + kt * 32768 + 16384 + r * 128 + ((lc ^ (r & 7)) << 4)) = wv[i]; }
    {
        const int lane = tid & 63, w = tid >> 6, wr = w >> 1, wc = w & 1, fr = lane & 15, fq = lane >> 4;
#pragma unroll
        for (int i = 0; i < 4; ++i)
#pragma unroll
            for (int j = 0; j < 4; ++j) { const bf16_t* q = ZB + (size_t)(row0 + wr * 64 + i * 16 + fr) * 512 + pg * 128 + wc * 64 + j * 16 + fq * 4; GLD8(zz[i][j], q); }
    }
    __syncthreads();
    mma_ktile(acc, lds, tid); mma_ktile(acc, lds + 32768, tid);
    asm volatile("s_waitcnt vmcnt(0)" : "+v"(zz[0][0]), "+v"(zz[0][1]), "+v"(zz[0][2]), "+v"(zz[0][3]) :: "memory");
    PIN4(zz[1][0], zz[1][1], zz[1][2], zz[1][3]); PIN4(zz[2][0], zz[2][1], zz[2][2], zz[2][3]); PIN4(zz[3][0], zz[3][1], zz[3][2], zz[3][3]);
    __syncthreads();
}

namespace pg8 {
#define PG8_LAS __attribute__((address_space(3)))
typedef unsigned short bf16_t;
typedef short bf16x8 __attribute__((ext_vector_type(8)));
typedef float f32x4 __attribute__((ext_vector_type(4)));
typedef unsigned u32x4 __attribute__((ext_vector_type(4)));
constexpr int BM = 256, BK = 64, HALF = 128, HTB = HALF * BK * 2  , STAGE_BYTES = 8 * HTB, NXCD = 8, WGM = 8;

__host__ __device__ __forceinline__ int lds_byte(int r, int c) { const int st = (r >> 4) * 2 + (c >> 5), rr = r & 15, cc = c & 31, ob = rr * 64 + cc * 2; return st * 1024 + (ob ^ (((ob >> 9) & 1) << 5)); }
__host__ __device__ __forceinline__ void stage_rc(int b, int& R, int& C) { const int st = b / 1024, sb = b % 1024, swz = sb ^ (((sb >> 9) & 1) << 5); R = (st >> 1) * 16 + swz / 64; C = (st & 1) * 32 + (swz % 64) / 2; }
__host__ __device__ __forceinline__ int perm32(int rho) { const int n = rho >> 4, i = rho & 15; return 8 * (i >> 2) + 4 * n + (i & 3); }

struct Unit { int pm, pn; };
struct Gemm { const bf16_t* A; const bf16_t* Bt; int M, N, K; };

struct StaticOrder {
    int nM, nN, nwg, G, c;
    __host__ __device__ void init(int M, int N, int G_, int c_) { nM = M / BM; nN = N / BM; nwg = nM * nN; G = G_; c = c_; }
    __host__ __device__ bool next(int i, Unit& u) const {
        const long L = (long)i * G + c; if (L >= nwg) return false;
        int wgid = (int)L; { const int q = nwg / NXCD, r = nwg % NXCD, xcd = wgid % NXCD, off = wgid / NXCD; wgid = (xcd < r ? xcd * (q + 1) : r * (q + 1) + (xcd - r) * q) + off; }
        const int nig = WGM * nN, gid = wgid / nig, fm = gid * WGM, gsz = (nM - fm) < WGM ? (nM - fm) : WGM;
        u.pm = fm + ((wgid % nig) % gsz); u.pn = (wgid % nig) / gsz; return true;
    }
    __device__ __forceinline__ void a_ready(const Unit&) const {}
    __device__ __forceinline__ void done(const Unit&) const {}
};

__device__ __forceinline__ unsigned cvt_pk_bf16(float lo, float hi) { unsigned r; asm volatile("v_cvt_pk_bf16_f32 %0, %1, %2" : "=v"(r) : "v"(lo), "v"(hi)); return r; }

template <class Epi, class Sched, bool ALIGN_EPI = false, bool SP2 = false>
__device__ __forceinline__ void gemm_phase(PG8_LAS unsigned char* lds, const Gemm g, const Sched& S, const Epi& E) {
    const int tid = threadIdx.x, wid = __builtin_amdgcn_readfirstlane(tid >> 6), lane = tid & 63, wr = wid >> 2, wc = wid & 3, fr = lane & 15, fq = lane >> 4;
    const int K = g.K, nt = K / BK;
    unsigned voffA[2], voffB[2];
#pragma unroll
    for (int i = 0; i < 2; ++i) { int R, C; stage_rc(tid * 16 + i * 8192, R, C); const int Rb = Epi::PERM ? ((R & ~31) + perm32(R & 31)) : R;
        voffA[i] = (unsigned)(R * K + C) * 2u; voffB[i] = (unsigned)(Rb * K + C) * 2u; }
    const size_t kstep = (size_t)(BK * 2);
    const size_t hstep = (size_t)HALF * K * 2;
    const size_t tstep = 2 * hstep;
    const unsigned ldsw = (unsigned)wid * 1024u;
    const int aoff = lds_byte(wr * 64 + fr, fq * 8), boff = lds_byte(wc * 32 + fr, fq * 8);
#define PG8_SA(b, h) (((b) * 2 + (h)) * HTB)
#define PG8_SB(b, h) ((4 + (b) * 2 + (h)) * HTB)
#define PG8_STAGE(bufoff, gbase, voff) do { _Pragma("unroll") for (int _i = 0; _i < 2; ++_i) \
        __builtin_amdgcn_global_load_lds((const unsigned*)((const char*)(gbase) + (voff)[_i]), (PG8_LAS unsigned*)(lds + (bufoff) + ldsw + _i * 8192), 16, 0, 0); } while (0)
#define PG8_LDA(dst, b, h) do { _Pragma("unroll") for (int m = 0; m < 4; ++m) _Pragma("unroll") for (int k = 0; k < 2; ++k) dst[m][k] = *(const PG8_LAS bf16x8*)(lds + PG8_SA(b, h) + aoff + m * 2048 + k * 1024); } while (0)
#define PG8_LDB(dst, b, h) do { _Pragma("unroll") for (int n = 0; n < 2; ++n) _Pragma("unroll") for (int k = 0; k < 2; ++k) dst[n][k] = *(const PG8_LAS bf16x8*)(lds + PG8_SB(b, h) + boff + n * 2048 + k * 1024); } while (0)
#define PG8_MMA(ai, bj, At, Bt) do { __builtin_amdgcn_s_setprio(1); _Pragma("unroll") for (int m = 0; m < 4; ++m) _Pragma("unroll") for (int n = 0; n < 2; ++n) _Pragma("unroll") for (int k = 0; k < 2; ++k) \
        acc[ai][bj][m][n] = __builtin_amdgcn_mfma_f32_16x16x32_bf16(Bt[n][k], At[m][k], acc[ai][bj][m][n], 0, 0, 0); __builtin_amdgcn_s_setprio(0); } while (0)
#define PG8_WAIT_V(n) asm volatile("s_waitcnt vmcnt(" #n ")" ::: "memory")
#define PG8_WAIT_L(n) asm volatile("s_waitcnt lgkmcnt(" #n ")" ::: "memory")
#define PG8_BAR __builtin_amdgcn_s_barrier()
#define PG8_SCHED __builtin_amdgcn_sched_barrier(0)
    Unit cur, nxt; int ui = 0;
    if (!S.next(0, cur)) return;
    f32x4 acc[2][2][4][2];
#pragma unroll
    for (int a = 0; a < 2; ++a)
#pragma unroll
        for (int b = 0; b < 2; ++b)
#pragma unroll
            for (int m = 0; m < 4; ++m)
#pragma unroll
                for (int n = 0; n < 2; ++n) acc[a][b][m][n] = (f32x4){0.f, 0.f, 0.f, 0.f};
    bf16x8 At[4][2], B0[2][2], B1[2][2];
    const char* cA = (const char*)g.A + (size_t)cur.pm * tstep; const char* cB = (const char*)g.Bt + (size_t)cur.pn * tstep;
    S.a_ready(cur);
    if constexpr (SP2) {
        PG8_STAGE(PG8_SB(0, 0), cB, voffB); PG8_STAGE(PG8_SB(0, 1), cB + hstep, voffB); PG8_STAGE(PG8_SA(0, 0), cA, voffA); PG8_STAGE(PG8_SA(0, 1), cA + hstep, voffA);
        if (wr == 1) PG8_BAR;
        PG8_WAIT_V(2); PG8_BAR;
        PG8_STAGE(PG8_SB(1, 0), cB + kstep, voffB); PG8_STAGE(PG8_SA(1, 0), cA + kstep, voffA); PG8_STAGE(PG8_SB(1, 1), cB + hstep + kstep, voffB);
        PG8_WAIT_V(6); PG8_BAR;
    } else {
        PG8_STAGE(PG8_SB(0, 0), cB, voffB); PG8_STAGE(PG8_SA(0, 0), cA, voffA); PG8_STAGE(PG8_SB(0, 1), cB + hstep, voffB); PG8_STAGE(PG8_SA(0, 1), cA + hstep, voffA);
        if (wr == 1) PG8_BAR;
        PG8_WAIT_V(4); PG8_BAR;
        PG8_STAGE(PG8_SB(1, 0), cB + kstep, voffB); PG8_STAGE(PG8_SA(1, 0), cA + kstep, voffA); PG8_STAGE(PG8_SB(1, 1), cB + hstep + kstep, voffB);
        PG8_WAIT_V(6); PG8_BAR;
    }
    for (;;) {
        const bool has_next = S.next(ui + 1, nxt);
        const char* nA = has_next ? (const char*)g.A + (size_t)nxt.pm * tstep : cA; const char* nB = has_next ? (const char*)g.Bt + (size_t)nxt.pn * tstep : cB;
        for (int t = 0; t < nt; t += 2) {
            const bool last = (t == nt - 2);
            const char* a1 = cA + (size_t)(t + 1) * kstep;
            const char* a2 = last ? nA : cA + (size_t)(t + 2) * kstep; const char* b2 = last ? nB : cB + (size_t)(t + 2) * kstep;
            const char* a3 = a2 + kstep; const char* b3 = b2 + kstep;
            if (last && has_next) S.a_ready(nxt);
            if constexpr (SP2) {
            PG8_LDB(B0, 0, 0); PG8_LDB(B1, 0, 1); PG8_SCHED; PG8_LDA(At, 0, 0); PG8_STAGE(PG8_SA(1, 1), a1 + hstep, voffA);
            PG8_WAIT_V(8); PG8_WAIT_L(0); PG8_BAR; PG8_MMA(0, 0, At, B0); PG8_MMA(0, 1, At, B1); PG8_BAR; PG8_SCHED;
            PG8_LDA(At, 0, 1); PG8_STAGE(PG8_SB(0, 0), b2, voffB); PG8_STAGE(PG8_SB(0, 1), b2 + hstep, voffB); PG8_STAGE(PG8_SA(0, 0), a2, voffA);
            PG8_WAIT_V(8); PG8_WAIT_L(0); PG8_BAR; PG8_MMA(1, 0, At, B0); PG8_MMA(1, 1, At, B1); PG8_BAR; PG8_SCHED;
            PG8_LDB(B0, 1, 0); PG8_LDB(B1, 1, 1); PG8_SCHED; PG8_LDA(At, 1, 0); PG8_STAGE(PG8_SA(0, 1), a2 + hstep, voffA);
            PG8_WAIT_V(8); PG8_WAIT_L(0); PG8_BAR; PG8_MMA(0, 0, At, B0); PG8_MMA(0, 1, At, B1); PG8_BAR; PG8_SCHED;
            PG8_LDA(At, 1, 1); PG8_STAGE(PG8_SB(1, 0), b3, voffB); PG8_STAGE(PG8_SB(1, 1), b3 + hstep, voffB); PG8_STAGE(PG8_SA(1, 0), a3, voffA);
            PG8_WAIT_V(8); PG8_WAIT_L(0); PG8_BAR; PG8_MMA(1, 0, At, B0); PG8_MMA(1, 1, At, B1); PG8_BAR; PG8_SCHED;
            } else {
            PG8_LDB(B0, 0, 0); PG8_SCHED; PG8_LDA(At, 0, 0); PG8_STAGE(PG8_SA(1, 1), a1 + hstep, voffA);
            PG8_WAIT_L(8); PG8_BAR; PG8_WAIT_L(0); PG8_MMA(0, 0, At, B0); PG8_BAR; PG8_SCHED;
            PG8_LDB(B1, 0, 1); PG8_STAGE(PG8_SB(0, 0), b2, voffB);
            PG8_BAR; PG8_WAIT_L(0); PG8_MMA(0, 1, At, B1); PG8_BAR;
            PG8_LDA(At, 0, 1); PG8_STAGE(PG8_SA(0, 0), a2, voffA);
            PG8_BAR; PG8_WAIT_L(0); PG8_MMA(1, 0, At, B0); PG8_BAR; PG8_SCHED;
            PG8_STAGE(PG8_SB(0, 1), b2 + hstep, voffB);
            PG8_WAIT_V(6); PG8_BAR; PG8_MMA(1, 1, At, B1); PG8_BAR;
            PG8_LDB(B0, 1, 0); PG8_SCHED; PG8_LDA(At, 1, 0); PG8_STAGE(PG8_SA(0, 1), a2 + hstep, voffA);
            PG8_WAIT_L(8); PG8_BAR; PG8_WAIT_L(0); PG8_MMA(0, 0, At, B0); PG8_BAR; PG8_SCHED;
            PG8_LDB(B1, 1, 1); PG8_STAGE(PG8_SB(1, 0), b3, voffB);
            PG8_BAR; PG8_WAIT_L(0); PG8_MMA(0, 1, At, B1); PG8_BAR;
            PG8_LDA(At, 1, 1); PG8_STAGE(PG8_SA(1, 0), a3, voffA);
            PG8_BAR; PG8_WAIT_L(0); PG8_MMA(1, 0, At, B0); PG8_BAR; PG8_SCHED;
            PG8_STAGE(PG8_SB(1, 1), b3 + hstep, voffB);
            PG8_WAIT_V(6); PG8_BAR; PG8_MMA(1, 1, At, B1); PG8_BAR;
            }
        }
        if constexpr (ALIGN_EPI) { if (wr == 0) PG8_BAR; }
        if constexpr (!Epi::AFTER_DRAIN) { E(acc, cur, wr, wc, fr, fq); S.done(cur); }
        if (!has_next) break;
#pragma unroll
        for (int a = 0; a < 2; ++a)
#pragma unroll
            for (int b = 0; b < 2; ++b)
#pragma unroll
                for (int m = 0; m < 4; ++m)
#pragma unroll
                    for (int n = 0; n < 2; ++n) acc[a][b][m][n] = (f32x4){0.f, 0.f, 0.f, 0.f};
        cur = nxt; cA = nA; cB = nB; ++ui;
        if constexpr (ALIGN_EPI) { if (wr == 1) PG8_BAR; }
    }
    PG8_WAIT_V(0);
    if constexpr (!ALIGN_EPI) { if (wr == 0) PG8_BAR; }
    PG8_BAR;
    if constexpr (Epi::AFTER_DRAIN) { E.fused(acc, cur, wr, wc, fr, fq, lds, wid, lane); S.done(cur); }
#undef PG8_SA
#undef PG8_SB
#undef PG8_STAGE
#undef PG8_LDA
#undef PG8_LDB
#undef PG8_MMA
#undef PG8_WAIT_V
#undef PG8_WAIT_L
#undef PG8_BAR
#undef PG8_SCHED
}
}

__device__ __forceinline__ void transpose_load(const float* __restrict__ src, int N, int k0, int n0, float* tile, int tid) {
#pragma unroll
    for (int i = 0; i < 4; ++i) { const int k = (tid >> 4) + 16 * i, n4 = (tid & 15) * 4;
        const f32x4 v = *(const f32x4*)(src + (size_t)(k0 + k) * N + n0 + n4);
        tile[k * 65 + n4] = v.x; tile[k * 65 + n4 + 1] = v.y; tile[k * 65 + n4 + 2] = v.z; tile[k * 65 + n4 + 3] = v.w; }
}
__device__ __forceinline__ void transpose_store(bf16_t* __restrict__ dst, int K, int k0, int n0, const float* tile, int tid) {
#pragma unroll
    for (int i = 0; i < 2; ++i) { const int n = (tid >> 3) + 32 * i, kc = (tid & 7) * 8; const float* s = tile + kc * 65 + n;
        u32x4 o; o.x = pk2(s[0], s[65]); o.y = pk2(s[2 * 65], s[3 * 65]); o.z = pk2(s[4 * 65], s[5 * 65]); o.w = pk2(s[6 * 65], s[7 * 65]);
        *(u32x4*)(dst + (size_t)(n0 + n) * K + k0 + kc) = o; }
}
__device__ __forceinline__ void ssm_tables_item(const Params& P, int item, unsigned char* lds) {
    const int tid = threadIdx.x, l = item >> 7, g = (item >> 2) & 31, tq = item & 3, lg = l * 32 + g;
    constexpr int PS = 36;
    float* pwr = (float*)lds;
    float* pwi = pwr + 64 * PS;
    float* bbr = pwi + 64 * PS;
    float* bbi = bbr + 1024;
    float* ccr = bbi + 1024;
    float* cci = ccr + 1024;
    float* cf = cci + 1024;
    float* ktab = cf + 128;
    unsigned char* wl = P.ws + OFF_W + (size_t)l * WL_SIZE;
    bf16_t* M13 = (bf16_t*)(wl + WL_M13) + (size_t)g * KI * KA;
    bf16_t* M2 = (bf16_t*)(wl + WL_M2) + (size_t)g * 128 * KI;
    if (tid < 64) {
        const int p = tid;
        const double dt = exp((double)P.log_dt[lg]);
        const double lr = (double)P.lam_re[lg * 64 + p], li = (double)P.lam_im[lg * 64 + p];
        const double mag = exp(lr * dt), ang = li * dt;
        const double ar = mag * cos(ang), ai = mag * sin(ang);
        const double nr = ar - 1.0, ni = ai, den = lr * lr + li * li;
        cf[2 * p] = (float)((nr * lr + ni * li) / den); cf[2 * p + 1] = (float)((ni * lr - nr * li) / den);
        double pr = 1.0, pi = 0.0;
        for (int k = 0; k <= QC; ++k) { pwr[p * PS + k] = (float)pr; pwi[p * PS + k] = (float)pi; const double t = pr * ar - pi * ai; pi = pr * ai + pi * ar; pr = t; }
    }
    for (int i = tid; i < 1024; i += NTHR) { ccr[i] = P.c_re[(size_t)lg * 1024 + i]; cci[i] = P.c_im[(size_t)lg * 1024 + i]; }
    __syncthreads();
    for (int i = tid; i < 1024; i += NTHR) { const int p = i >> 4; const float br = P.b_re[(size_t)lg * 1024 + i], bi = P.b_im[(size_t)lg * 1024 + i], cr = cf[2 * p], ci = cf[2 * p + 1];
        bbr[i] = cr * br - ci * bi; bbi[i] = cr * bi + ci * br; }
    __syncthreads();
    {
        const int co = (tid >> 4) & 15, ci = tid & 15, kh = tid >> 8;
        f32x4 a[2];
#pragma unroll
        for (int q = 0; q < 2; ++q) a[q] = (f32x4){0.f, 0.f, 0.f, 0.f};
        for (int p = 0; p < 64; ++p) {
            const float xr = ccr[co * 64 + p], xi = cci[co * 64 + p], yr = bbr[p * 16 + ci], yi = bbi[p * 16 + ci];
            const float cbr = xr * yr - xi * yi, cbi = xr * yi + xi * yr;
#pragma unroll
            for (int q = 0; q < 2; ++q) a[q] += cbr * *(const f32x4*)(pwr + p * PS + kh * 8 + q * 4) - cbi * *(const f32x4*)(pwi + p * PS + kh * 8 + q * 4);
        }
#pragma unroll
        for (int q = 0; q < 2; ++q) { ktab[(kh * 8 + q * 4 + 0) * 256 + (tid & 255)] = a[q].x; ktab[(kh * 8 + q * 4 + 1) * 256 + (tid & 255)] = a[q].y;
            ktab[(kh * 8 + q * 4 + 2) * 256 + (tid & 255)] = a[q].z; ktab[(kh * 8 + q * 4 + 3) * 256 + (tid & 255)] = a[q].w; }
    }
    __syncthreads();
    for (int idx = tid; idx < 64 * (KI / 8); idx += NTHR) {
        const int nl = idx / (KI / 8), kc = idx % (KI / 8), t = tq * (QC / 4) + (nl >> 4), co = nl & 15, s = kc >> 1, ci0 = (kc & 1) * 8, lag = t - s;
        u32x4 o = {0u, 0u, 0u, 0u};
        if (lag >= 0) { const f32x4 k0 = *(const f32x4*)(ktab + lag * 256 + co * 16 + ci0), k1 = *(const f32x4*)(ktab + lag * 256 + co * 16 + ci0 + 4); o = pk8(k0, k1); }
        *(u32x4*)(M13 + (size_t)(t * 16 + co) * KA + kc * 8) = o;
    }
    for (int idx = tid; idx < 64 * 16; idx += NTHR) {
        const int nl = idx >> 4, pc = idx & 15, t = tq * (QC / 4) + (nl >> 4), co = nl & 15;
        float vv[8];
#pragma unroll
        for (int pp = 0; pp < 4; ++pp) { const int p = pc * 4 + pp; const float cr = ccr[co * 64 + p], ci = cci[co * 64 + p], wr = pwr[p * PS + t + 1], wi = pwi[p * PS + t + 1];
            vv[2 * pp] = cr * wr - ci * wi; vv[2 * pp + 1] = -(cr * wi + ci * wr); }
        u32x4 o; o.x = pk2(vv[0], vv[1]); o.y = pk2(vv[2], vv[3]); o.z = pk2(vv[4], vv[5]); o.w = pk2(vv[6], vv[7]);
        *(u32x4*)(M13 + (size_t)(t * 16 + co) * KA + KI + pc * 8) = o;
    }
    for (int idx = tid; idx < 32 * (KI / 8); idx += NTHR) {
        const int n2 = tq * 32 + idx / (KI / 8), kc = idx % (KI / 8), p = n2 >> 1, ri = n2 & 1, s = kc >> 1, ci0 = (kc & 1) * 8;
        const float wr = pwr[p * PS + (QC - 1) - s], wi = pwi[p * PS + (QC - 1) - s];
        float vv[8];
#pragma unroll
        for (int j = 0; j < 8; ++j) { const float br = bbr[p * 16 + ci0 + j], bi = bbi[p * 16 + ci0 + j]; vv[j] = ri ? (wr * bi + wi * br) : (wr * br - wi * bi); }
        u32x4 o; o.x = pk2(vv[0], vv[1]); o.y = pk2(vv[2], vv[3]); o.z = pk2(vv[4], vv[5]); o.w = pk2(vv[6], vv[7]);
        *(u32x4*)(M2 + (size_t)n2 * KI + kc * 8) = o;
    }
    if (tq == 0 && tid < 64) { float* aq = (float*)(P.ws + OFF_AQ) + (size_t)(lg * 64 + tid) * 2; aq[0] = pwr[tid * PS + QC]; aq[1] = pwi[tid * PS + QC]; }
    __syncthreads();
}
struct TItem { const float* src; bf16_t* dst; int K, N, k0, n0; };
__device__ __forceinline__ TItem decode_titem(const Params& P, int it) {
    constexpr int I_IN = 16 * 64, I_GLU = 64, I_POOL = 16, I_A = 128, I_B = 128, I_OUT = 256, I_L = I_IN + I_GLU + I_POOL + I_A + I_B + I_OUT;
    const int l = it / I_L; int r = it % I_L;
    unsigned char* wl = P.ws + OFF_W + (size_t)l * WL_SIZE;
    TItem t; int kb, nb;
    if (r < I_IN) { t.src = P.w_in + (size_t)l * 1024 * 4096; t.dst = (bf16_t*)(wl + WL_WIN); t.K = 1024; t.N = 4096; kb = r / 64; nb = r % 64; }
    else if ((r -= I_IN) < I_GLU) { t.src = P.w_glu + (size_t)l * 512 * 512; t.dst = (bf16_t*)(wl + WL_WGLU); t.K = 512; t.N = 512; kb = r / 8; nb = r % 8; }
    else if ((r -= I_GLU) < I_POOL) { const int pg = r >> 2; t.src = P.pool_w + (size_t)(l * 4 + pg) * 128 * 128; t.dst = (bf16_t*)(wl + WL_POOL) + pg * 128 * 128; t.K = 128; t.N = 128; kb = (r >> 1) & 1; nb = r & 1; }
    else if ((r -= I_POOL) < I_A) { t.src = P.w_a + (size_t)l * 512 * 1024; t.dst = (bf16_t*)(wl + WL_WA); t.K = 512; t.N = 1024; kb = r / 16; nb = r % 16; }
    else if ((r -= I_A) < I_B) { t.src = P.w_b + (size_t)l * 512 * 1024; t.dst = (bf16_t*)(wl + WL_WB); t.K = 512; t.N = 1024; kb = r / 16; nb = r % 16; }
    else { r -= I_B; t.src = P.w_out + (size_t)l * 1024 * 1024; t.dst = (bf16_t*)(wl + WL_WOUT); t.K = 1024; t.N = 1024; kb = r / 16; nb = r % 16; }
    t.k0 = kb * 64; t.n0 = nb * 64; return t;
}
__device__ __forceinline__ void phase_prologue(const Params& P, unsigned char* lds, int part, int wb, int nw) {
    const int tid = threadIdx.x, G = gridDim.x, half = tid >> 8, t2 = tid & 255;
    constexpr int N_TITEMS = 2 * (16 * 64 + 64 + 16 + 128 + 128 + 256);
    float* tile = (float*)lds + half * (2 * 64 * 65);
    for (int it0 = part * (N_TITEMS / 2) + wb * 4; it0 < (part + 1) * (N_TITEMS / 2); it0 += 4 * nw) {
        const TItem ta = decode_titem(P, it0 + half * 2), tb = decode_titem(P, it0 + half * 2 + 1);
        transpose_load(ta.src, ta.N, ta.k0, ta.n0, tile, t2);
        transpose_load(tb.src, tb.N, tb.k0, tb.n0, tile + 64 * 65, t2);
        __syncthreads();
        transpose_store(ta.dst, ta.K, ta.k0, ta.n0, tile, t2);
        transpose_store(tb.dst, tb.K, tb.k0, tb.n0, tile + 64 * 65, t2);
        __syncthreads();
    }
    for (int it = part * 128 + wb; it < (part + 1) * 128; it += nw) ssm_tables_item(P, it, lds);
    if (part != 0) return;
    float* ss = (float*)(P.ws + OFF_SS);
    for (int i = blockIdx.x * NTHR + tid; i < 2 * T; i += G * NTHR) ss[T + i] = 0.f;
    bf16_t* H = (bf16_t*)(P.ws + OFF_H);
    const int lane = tid & 63, wid = tid >> 6;
    for (int it = blockIdx.x; it < T / 8; it += G) {
        const int row = it * 8 + wid;
        const float* xr = P.x + (size_t)row * DM;
        float s = 0.f;
#pragma unroll
        for (int j = 0; j < 4; ++j) { const int c = lane * 4 + 256 * j; const f32x4 v = *(const f32x4*)(xr + c); const f32x4 gg = *(const f32x4*)(P.norm_g + c);
            s += (v.x * v.x + v.y * v.y) + (v.z * v.z + v.w * v.w);
            *(u32x2*)(H + (size_t)row * DM + c) = pk4(v * gg); }
#pragma unroll
        for (int o = 1; o < 64; o <<= 1) s += __shfl_xor(s, o);
        if (lane == 0) ss[row] = s;
    }
}

typedef f32x4 Acc8[2][2][4][2];
#define PG_EPI_ROWS(...) _Pragma("unroll") for (int ai = 0; ai < 2; ++ai) _Pragma("unroll") for (int m = 0; m < 4; ++m) { const int row = u.pm * 256 + ai * 128 + wr * 64 + m * 16 + fr; __VA_ARGS__ }
#define PG_EPI_COLS(...) _Pragma("unroll") for (int bj = 0; bj < 2; ++bj) { const int col = u.pn * 256 + bj * 128 + wc * 32 + 8 * fq; const f32x4 v0 = acc[ai][bj][m][0], v1 = acc[ai][bj][m][1]; __VA_ARGS__ }
__device__ __forceinline__ f32x4 sigm4(f32x4 a) { f32x4 r; r.x = sigm(a.x); r.y = sigm(a.y); r.z = sigm(a.z); r.w = sigm(a.w); return r; }
__device__ __forceinline__ f32x4 silu4(f32x4 a) { return a * sigm4(a); }

#define ROW_OF(ai, m) (u.pm * 256 + (ai) * 128 + wr * 64 + (m) * 16 + fr)
#define COL_OF(bj) (u.pn * 256 + (bj) * 128 + wc * 32 + 8 * fq)
#define UNR _Pragma("unroll")
struct EpiProj { static constexpr bool PERM = true, AFTER_DRAIN = false;
    const float* ss; const float* bias; unsigned char* ws;
    __device__ __forceinline__ void operator()(const Acc8& acc, const pg8::Unit& u, int wr, int wc, int fr, int fq) const {
        const int pn = u.pn; bf16_t* dst; int ldd, cbase;
        if (pn < 2) { dst = (bf16_t*)(ws + OFF_UAP); ldd = 0; cbase = 0; }
        else if (pn < 4) { dst = (bf16_t*)(ws + OFF_ZA); ldd = 512; cbase = 512; }
        else if (pn < 6) { dst = (bf16_t*)(ws + OFF_UB); ldd = 512; cbase = 1024; }
        else if (pn < 8) { dst = (bf16_t*)(ws + OFF_ZB); ldd = 512; cbase = 1536; }
        else if (pn < 12) { dst = (bf16_t*)(ws + OFF_GA); ldd = 1024; cbase = 2048; }
        else { dst = (bf16_t*)(ws + OFF_GB); ldd = 1024; cbase = 3072; }
        f32x4 bv[2][2]; float inv[2][4];
        UNR for (int bj = 0; bj < 2; ++bj) { bv[bj][0] = *(const f32x4*)(bias + COL_OF(bj)); bv[bj][1] = *(const f32x4*)(bias + COL_OF(bj) + 4); }
        UNR for (int ai = 0; ai < 2; ++ai) UNR for (int m = 0; m < 4; ++m) inv[ai][m] = ss[ROW_OF(ai, m)];
        UNR for (int ai = 0; ai < 2; ++ai) UNR for (int m = 0; m < 4; ++m) inv[ai][m] = rsqrtf(inv[ai][m] * (1.f / DM) + EPS);
        UNR for (int ai = 0; ai < 2; ++ai) UNR for (int m = 0; m < 4; ++m) { const int row = ROW_OF(ai, m);
            UNR for (int bj = 0; bj < 2; ++bj) { const int col = COL_OF(bj);
                const u32x4 w = pk8(acc[ai][bj][m][0] * inv[ai][m] + bv[bj][0], acc[ai][bj][m][1] * inv[ai][m] + bv[bj][1]);
                if (pn < 2) *(u32x4*)(dst + ((size_t)((col >> 4) * MG + (row >> QSH)) * KA + (row & (QC - 1)) * 16 + (col & 15))) = w;
                else *(u32x4*)(dst + (size_t)row * ldd + (col - cbase)) = w; } }
    }
};
struct EpiGlu { static constexpr bool PERM = true, AFTER_DRAIN = false;
    const bf16_t* YP; const bf16_t* ZA; bf16_t* YA; const float* bg;
    __device__ __forceinline__ void operator()(const Acc8& acc, const pg8::Unit& u, int wr, int wc, int fr, int fq) const {
        f32x4 bv[2][2];
        UNR for (int bj = 0; bj < 2; ++bj) { bv[bj][0] = *(const f32x4*)(bg + COL_OF(bj)); bv[bj][1] = *(const f32x4*)(bg + COL_OF(bj) + 4); }
        UNR for (int ai = 0; ai < 2; ++ai) {
            u32x4 yv[4][2], zv[4][2];
            UNR for (int m = 0; m < 4; ++m) UNR for (int bj = 0; bj < 2; ++bj) { const size_t o = (size_t)ROW_OF(ai, m) * 512 + COL_OF(bj); yv[m][bj] = *(const u32x4*)(YP + o); zv[m][bj] = *(const u32x4*)(ZA + o); }
            UNR for (int m = 0; m < 4; ++m) UNR for (int bj = 0; bj < 2; ++bj) {
                f32x4 y0, y1, z0, z1; unpk8(yv[m][bj], y0, y1); unpk8(zv[m][bj], z0, z1);
                const f32x4 o0 = y0 * sigm4(acc[ai][bj][m][0] + bv[bj][0]) * silu4(z0), o1 = y1 * sigm4(acc[ai][bj][m][1] + bv[bj][1]) * silu4(z1);
                *(u32x4*)(YA + (size_t)ROW_OF(ai, m) * 512 + COL_OF(bj)) = pk8(o0, o1); }
        }
    }
};
template <int PASS> struct EpiMerge { static constexpr bool PERM = true, AFTER_DRAIN = false;
    bf16_t* GA; const bf16_t* GB;
    __device__ __forceinline__ void operator()(const Acc8& acc, const pg8::Unit& u, int wr, int wc, int fr, int fq) const {
        UNR for (int ai = 0; ai < 2; ++ai) {
            u32x4 av[4][2], bv[4][2];
            UNR for (int m = 0; m < 4; ++m) UNR for (int bj = 0; bj < 2; ++bj) { const size_t o = (size_t)ROW_OF(ai, m) * DM + COL_OF(bj); av[m][bj] = *(const u32x4*)(GA + o); if (PASS == 1) bv[m][bj] = *(const u32x4*)(GB + o); }
            UNR for (int m = 0; m < 4; ++m) UNR for (int bj = 0; bj < 2; ++bj) {
                f32x4 a0, a1, o0, o1; unpk8(av[m][bj], a0, a1);
                if (PASS == 0) { o0 = sigm4(a0) * acc[ai][bj][m][0]; o1 = sigm4(a1) * acc[ai][bj][m][1]; }
                else { f32x4 b0, b1; unpk8(bv[m][bj], b0, b1); o0 = a0 + sigm4(b0) * acc[ai][bj][m][0]; o1 = a1 + sigm4(b1) * acc[ai][bj][m][1]; }
                *(u32x4*)(GA + (size_t)ROW_OF(ai, m) * DM + COL_OF(bj)) = pk8(o0, o1); }
        }
    }
};
template <int L> struct EpiOut { static constexpr bool PERM = true, AFTER_DRAIN = false;
    const float* xin; float* xout; float* ssn; bf16_t* H; const float* gn;
    __device__ __forceinline__ void operator()(const Acc8& acc, const pg8::Unit& u, int wr, int wc, int fr, int fq) const {
        f32x4 gv[2][2];
        if (L == 0) { UNR for (int bj = 0; bj < 2; ++bj) { gv[bj][0] = *(const f32x4*)(gn + COL_OF(bj)); gv[bj][1] = *(const f32x4*)(gn + COL_OF(bj) + 4); } }
        UNR for (int ai = 0; ai < 2; ++ai) UNR for (int mh = 0; mh < 2; ++mh) {
            f32x4 xv[2][2][2];
            UNR for (int mm = 0; mm < 2; ++mm) UNR for (int bj = 0; bj < 2; ++bj) { const float* p = xin + (size_t)ROW_OF(ai, mh * 2 + mm) * DM + COL_OF(bj); xv[mm][bj][0] = *(const f32x4*)p; xv[mm][bj][1] = *(const f32x4*)(p + 4); }
            UNR for (int mm = 0; mm < 2; ++mm) { const int m = mh * 2 + mm; const int row = ROW_OF(ai, m); float s = 0.f;
                UNR for (int bj = 0; bj < 2; ++bj) { const int col = COL_OF(bj);
                    const f32x4 o0 = xv[mm][bj][0] + acc[ai][bj][m][0], o1 = xv[mm][bj][1] + acc[ai][bj][m][1];
                    *(f32x4*)(xout + (size_t)row * DM + col) = o0; *(f32x4*)(xout + (size_t)row * DM + col + 4) = o1;
                    s += ((o0.x * o0.x + o0.y * o0.y) + (o0.z * o0.z + o0.w * o0.w)) + ((o1.x * o1.x + o1.y * o1.y) + (o1.z * o1.z + o1.w * o1.w));
                    if (L == 0) *(u32x4*)(H + (size_t)row * DM + col) = pk8(o0 * gv[bj][0], o1 * gv[bj][1]); }
                s += __shfl_xor(s, 16); s += __shfl_xor(s, 32);
                if (fq == 0) atomicAdd(ssn + row, s); }
        }
    }
};
struct EpiOutFinal { static constexpr bool PERM = true, AFTER_DRAIN = true;
    const float* xin; float* out; float* ssn; const float* fg; XcdBarrier xb; unsigned* grp; bool local;
    __device__ __forceinline__ void fused(Acc8& acc, const pg8::Unit& u, int wr, int wc, int fr, int fq, PG8_LAS unsigned char*, int, int) const {
        UNR for (int ai = 0; ai < 2; ++ai) {
            f32x4 xv[4][2][2];
            UNR for (int m = 0; m < 4; ++m) UNR for (int bj = 0; bj < 2; ++bj) { const float* p = xin + (size_t)ROW_OF(ai, m) * DM + COL_OF(bj); xv[m][bj][0] = *(const f32x4*)p; xv[m][bj][1] = *(const f32x4*)(p + 4); }
            UNR for (int m = 0; m < 4; ++m) { float s = 0.f;
                UNR for (int bj = 0; bj < 2; ++bj) {
                    const f32x4 o0 = xv[m][bj][0] + acc[ai][bj][m][0], o1 = xv[m][bj][1] + acc[ai][bj][m][1];
                    acc[ai][bj][m][0] = o0; acc[ai][bj][m][1] = o1;
                    s += ((o0.x * o0.x + o0.y * o0.y) + (o0.z * o0.z + o0.w * o0.w)) + ((o1.x * o1.x + o1.y * o1.y) + (o1.z * o1.z + o1.w * o1.w)); }
                s += __shfl_xor(s, 16); s += __shfl_xor(s, 32);
                if (fq == 0) atomicAdd(ssn + ROW_OF(ai, m), s); }
        }
        seam_sync(xb, grp, local);
        f32x4 gv[2][2]; float inv[2][4];
        UNR for (int bj = 0; bj < 2; ++bj) { gv[bj][0] = *(const f32x4*)(fg + COL_OF(bj)); gv[bj][1] = *(const f32x4*)(fg + COL_OF(bj) + 4); }
        UNR for (int ai = 0; ai < 2; ++ai) UNR for (int m = 0; m < 4; ++m) inv[ai][m] = __hip_atomic_load(ssn + ROW_OF(ai, m), __ATOMIC_RELAXED, __HIP_MEMORY_SCOPE_AGENT);
        UNR for (int ai = 0; ai < 2; ++ai) UNR for (int m = 0; m < 4; ++m) inv[ai][m] = rsqrtf(inv[ai][m] * (1.f / DM) + EPS);
        UNR for (int ai = 0; ai < 2; ++ai) UNR for (int m = 0; m < 4; ++m) UNR for (int bj = 0; bj < 2; ++bj) { float* p = out + (size_t)ROW_OF(ai, m) * DM + COL_OF(bj);
            *(f32x4*)p = (acc[ai][bj][m][0] * inv[ai][m]) * gv[bj][0]; *(f32x4*)(p + 4) = (acc[ai][bj][m][1] * inv[ai][m]) * gv[bj][1]; }
    }
};

template <class Epi>
__device__ __forceinline__ void big_gemm(unsigned char* lds, const bf16_t* A, const bf16_t* Bt, int N, int K, const Epi& E, int c) {
    pg8::Gemm g{A, Bt, T, N, K}; pg8::StaticOrder S; S.init(T, N, (int)gridDim.x, c);
    pg8::gemm_phase<Epi, pg8::StaticOrder, true, true>((PG8_LAS unsigned char*)lds, g, S, E);
}
__device__ __forceinline__ void phase_proj(const Params& P, int l, unsigned char* lds, int c) {
    const unsigned char* wl = P.ws + OFF_W + (size_t)l * WL_SIZE;
    EpiProj E{(const float*)(P.ws + OFF_SS) + (size_t)l * T, P.b_in + (size_t)l * 4096, P.ws};
    big_gemm(lds, (const bf16_t*)(P.ws + OFF_H), (const bf16_t*)(wl + WL_WIN), 4096, 1024, E, c);
}
__device__ __forceinline__ void phase_s5(const Params& P, int l, unsigned char* lds0, int c, bool local) {
    const unsigned char* wl = P.ws + OFF_W + (size_t)l * WL_SIZE;
    const int half = threadIdx.x >> 8; unsigned char* lds = lds0 + half * HALF_LDS;
    const float* dsk = P.d_skip + (size_t)l * 512; bf16_t* YP = (bf16_t*)(P.ws + OFF_YPRE);
    for (int tp = c; tp < 256; tp += gridDim.x) {
        int nt, g, mt;
        if (local) { const int x = tp & 7, j = tp >> 3; mt = x; nt = 1 - (j >> 4); g = (j & 15) * 2 + half; }
        else if (gridDim.x == 256) { const int x = tp & 7, j = tp >> 3, r = j & 7; g = x * 4 + (j >> 3); nt = r >> 2; mt = (r & 3) * 2 + half; }
        else { const int t = tp * 2 + half; nt = 1 - (t >> 8); g = (t >> 3) & 31; mt = t & 7; }
        bf16_t* U = (bf16_t*)(P.ws + OFF_UAP) + (size_t)(g * MG + mt * 128) * KA;
        f32x4 acc[4][4]; zero_acc(acc);
        gemm_mainloop(acc, LoadPlain{U, KA}, LoadPlain{(const bf16_t*)(wl + WL_M2) + (size_t)g * 128 * KI, KI}, KTI, lds);
        float* Sl = (float*)lds;
        EPI_LOOP( *(f32x4*)(Sl + m * 132 + n) = v; );
        __syncthreads();
        {
            int tid = threadIdx.x & 255; asm volatile("" : "+v"(tid));
            if (tid < 64) {
                const int p = tid;
                const float* aq = (const float*)(P.ws + OFF_AQ) + (size_t)((l * 32 + g) * 64 + p) * 2;
                const float ar = aq[0], ai = aq[1];
                float xr = 0.f, xi = 0.f;
#pragma unroll 8
                for (int c2 = 0; c2 < 128; ++c2) {
                    *(unsigned*)(U + (size_t)c2 * KA + KI + 2 * p) = pk2(xr, xi);
                    const float sr = Sl[c2 * 132 + 2 * p], si = Sl[c2 * 132 + 2 * p + 1];
                    const float nr = ar * xr - ai * xi + sr; xi = ar * xi + ai * xr + si; xr = nr;
                }
            }
            asm volatile("s_waitcnt vmcnt(0)" ::: "memory");
        }
        __syncthreads();
        const int nk1 = (nt + 1) * 2;
        zero_acc(acc);
        gemm_mainloop(acc, LoadRemap{U, KA, nk1}, LoadRemap{(const bf16_t*)(wl + WL_M13) + (size_t)(g * KI + nt * 128) * KA, KA, nk1}, nk1 + 2, lds);
        u32x2 uu[4][4]; f32x4 d4 = {0.f, 0.f, 0.f, 0.f};
        EPI_LOOP( uu[i][j] = *(const u32x2*)(U + (size_t)m * KA + nt * 128 + n); if (i == 0 && j == 0) d4 = *(const f32x4*)(dsk + g * 16 + (n & 15)); );
        EPI_LOOP(
            const int mm = mt * 128 + m, nn = nt * 128 + n, ch = g * 16 + (nn & 15);
            const f32x4 u = unpk4(uu[i][j]);
            f32x4 o; o.x = gelu_tanh(v.x + d4.x * u.x); o.y = gelu_tanh(v.y + d4.y * u.y); o.z = gelu_tanh(v.z + d4.z * u.z); o.w = gelu_tanh(v.w + d4.w * u.w);
            *(u32x2*)(YP + (size_t)(mm * QC + (nn >> 4)) * 512 + ch) = pk4(o);
        );
    }
}
__device__ __forceinline__ void pool_pairs(const Params& P, int l, unsigned char* lds0, int first, int end, int stride) {
    const unsigned char* wl = P.ws + OFF_W + (size_t)l * WL_SIZE;
    const int half = threadIdx.x >> 8; unsigned char* lds = lds0 + half * HALF_LDS;
    const bf16_t* ZB = (const bf16_t*)(P.ws + OFF_ZB); bf16_t* YB = (bf16_t*)(P.ws + OFF_YB); const float* sc = P.pool_scale + (size_t)l * 512;
    for (int tp = first; tp < end; tp += stride) {
        const int u = tp * 2 + half, pg = u & 3, mt = u >> 2;
        f32x4 acc[4][4]; zero_acc(acc);
        u32x2 zz[4][4]; f32x4 s4[4];
        {   int _t = threadIdx.x & 255; asm volatile("" : "+v"(_t));
#pragma unroll
            for (int j = 0; j < 4; ++j) s4[j] = *(const f32x4*)(sc + pg * 128 + ((_t >> 6) & 1) * 64 + j * 16 + ((_t & 63) >> 4) * 4); }
        pool_tile(acc, (const bf16_t*)(P.ws + OFF_UB), (const bf16_t*)(wl + WL_POOL) + (size_t)pg * 128 * 128, ZB, zz, mt * 128, pg, lds);
        EPI_LOOP(
            const int row = mt * 128 + m, col = pg * 128 + n;
            *(u32x2*)(YB + (size_t)row * 512 + col) = pk4(v * s4[j] * silu4(unpk4(zz[i][j])));
        );
    }
}
__device__ __forceinline__ void phase_glu(const Params& P, int l, unsigned char* lds, int c, bool local) {
    const unsigned char* wl = P.ws + OFF_W + (size_t)l * WL_SIZE;
    EpiGlu E{(const bf16_t*)(P.ws + OFF_YPRE), (const bf16_t*)(P.ws + OFF_ZA), (bf16_t*)(P.ws + OFF_YA), P.b_glu + (size_t)l * 512};
    big_gemm(lds, (const bf16_t*)(P.ws + OFF_YPRE), (const bf16_t*)(wl + WL_WGLU), 512, 512, E, c);
    const int G = (int)gridDim.x;
    if (local) { if (c >= 128) { const int pm = (c & 7) * 8 + ((c >> 3) & 7), mt = 2 * pm + (((c >> 3) - 16) >> 3); pool_pairs(P, l, lds, 2 * mt, 2 * mt + 2, 1); } }
    else if (G > 128) { if (c >= 128) pool_pairs(P, l, lds, c - 128, 256, G - 128); }
    else pool_pairs(P, l, lds, c, 256, G);
}
__device__ __forceinline__ void phase_merge(const Params& P, int l, unsigned char* lds, int c) {
    const unsigned char* wl = P.ws + OFF_W + (size_t)l * WL_SIZE;
#ifdef PROBE_M
    for (int rep = 0; rep < 2; ++rep) {
    EpiMerge<0> E0{rep == 0 ? (bf16_t*)(P.ws + OFF_UB) : (bf16_t*)(P.ws + OFF_GA), (const bf16_t*)(P.ws + OFF_GB)};
    big_gemm(lds, (const bf16_t*)(P.ws + OFF_YA), (const bf16_t*)(wl + WL_WA), 1024, 512, E0, c);
    }
#else
    EpiMerge<0> E0{(bf16_t*)(P.ws + OFF_GA), (const bf16_t*)(P.ws + OFF_GB)};
    big_gemm(lds, (const bf16_t*)(P.ws + OFF_YA), (const bf16_t*)(wl + WL_WA), 1024, 512, E0, c);
#endif
    EpiMerge<1> E1{(bf16_t*)(P.ws + OFF_GA), (const bf16_t*)(P.ws + OFF_GB)};
    big_gemm(lds, (const bf16_t*)(P.ws + OFF_YB), (const bf16_t*)(wl + WL_WB), 1024, 512, E1, c);
}
template <int L>
__device__ __forceinline__ void phase_out(const Params& P, unsigned char* lds, int c) {
    const unsigned char* wl = P.ws + OFF_W + (size_t)L * WL_SIZE;
#ifdef PROBE_O
    for (int rep = 0; rep < (L == 0 ? 2 : 1); ++rep) {
    EpiOut<L> E{L == 0 ? P.x : P.out, P.out, (L == 0 && rep == 0) ? (float*)(P.ws + OFF_S) : (float*)(P.ws + OFF_SS) + (size_t)(L + 1) * T, (bf16_t*)(P.ws + OFF_H), P.norm_g + (size_t)(L == 0 ? 1 : 0) * DM};
    big_gemm(lds, (const bf16_t*)(P.ws + OFF_GA), (const bf16_t*)(wl + WL_WOUT), 1024, 1024, E, c);
    }
#else
    EpiOut<L> E{L == 0 ? P.x : P.out, P.out, (float*)(P.ws + OFF_SS) + (size_t)(L + 1) * T, (bf16_t*)(P.ws + OFF_H), P.norm_g + (size_t)(L == 0 ? 1 : 0) * DM};
    big_gemm(lds, (const bf16_t*)(P.ws + OFF_GA), (const bf16_t*)(wl + WL_WOUT), 1024, 1024, E, c);
#endif
}
__device__ __forceinline__ void phase_out_final(const Params& P, unsigned char* lds, const XcdBarrier& xb, unsigned* grp, bool local, int c) {
    const unsigned char* wl = P.ws + OFF_W + (size_t)1 * WL_SIZE;
    EpiOutFinal E{P.out, P.out, (float*)(P.ws + OFF_SS) + (size_t)2 * T, P.final_g, xb, grp, local};
    pg8::Gemm g{(const bf16_t*)(P.ws + OFF_GA), (const bf16_t*)(wl + WL_WOUT), T, 1024, 1024}; pg8::StaticOrder S; S.init(T, 1024, (int)gridDim.x, c);
    pg8::gemm_phase<EpiOutFinal, pg8::StaticOrder, false, true>((PG8_LAS unsigned char*)lds, g, S, E);
}
__device__ __forceinline__ void phase_final(const Params& P) {
    const float* ss = (const float*)(P.ws + OFF_SS) + 2 * (size_t)T;
    for (int i = blockIdx.x * NTHR + threadIdx.x; i < T * (DM / 4); i += gridDim.x * NTHR) {
        const int row = i >> 8, c = (i & 255) * 4;
        const float inv = rsqrtf(ss[row] * (1.f / DM) + EPS);
        f32x4* p = (f32x4*)(P.out + (size_t)row * DM + c);
        *p = (*p * inv) * *(const f32x4*)(P.final_g + c);
    }
}

constexpr int N_PHASES = 12;
__global__ void __launch_bounds__(512, 2) hawk_fwd(Params P) {
    extern __shared__ __attribute__((aligned(16))) unsigned char lds[];
    volatile LAS unsigned* st = (volatile LAS unsigned*)(LAS unsigned char*)(lds + LDS_XB);
    const int lo = P.ph_lo, hi = P.ph_hi;
    XcdBarrier xb; xb.bar = (unsigned*)(P.ws + OFF_BAR); xb.x = 0; xb.st = st;
    if (hi - lo > 1) {
        if (threadIdx.x == 0) { st[0] = 0u; st[1] = 0u; st[2] = 0u; st[3] = 0u; st[4] = 0u; }
        __syncthreads();
        xb = xcd_barrier_post((unsigned*)(P.ws + OFF_BAR), st);
    }
#ifndef PROBE_DUP
#define PROBE_DUP -1
#endif
#define PH(k, ...) if (lo <= (k) && (k) < hi) { if ((k) > lo) xcd_barrier(xb); __VA_ARGS__; if (PROBE_DUP == (k)) { xcd_barrier(xb); __VA_ARGS__; } }
    const bool fuse_final = (gridDim.x == 256) && (lo == 0) && (hi == N_PHASES);
    PH(0, phase_prologue(P, lds, 0, (int)blockIdx.x, (int)gridDim.x))
    if (lo == 0 && hi == 1) phase_prologue(P, lds, 1, (int)blockIdx.x, (int)gridDim.x);
    int c = (int)blockIdx.x; bool even = false;
    if (lo == 0 && hi > 1) {
        xcd_barrier(xb);
        even = (gridDim.x % 8u) == 0u;
#pragma unroll
        for (unsigned j = 0; j < 16; ++j) { const unsigned n = xb_ld(&xb.bar[XB_XCNT(j)]); even = even && (n == (j < 8 ? gridDim.x / 8u : 0u)); }
        if (even) c = (int)(st[2] * 8u + xb.x);
    }
    const bool local = fuse_final && even;
    unsigned* grp = xb.bar + 4096 + 64 * ((c & 7) * 8 + ((c >> 3) & 7));
#undef PH
#define PH(k, ...) if (lo <= (k) && (k) < hi) { if ((k) > lo && (k) > 1) xcd_barrier(xb); __VA_ARGS__; if (PROBE_DUP == (k)) { xcd_barrier(xb); __VA_ARGS__; } }
#define PHS(k, ...) if (lo <= (k) && (k) < hi) { if ((k) > lo) seam_sync(xb, grp, local); __VA_ARGS__; }
#define PHX(k, ...) if (lo <= (k) && (k) < hi) { if ((k) > lo && (k) > 1) seam_sync_xcc(xb, xcnt, local); __VA_ARGS__; if (PROBE_DUP == (k)) { seam_sync_xcc(xb, xcnt, local); __VA_ARGS__; } }
    unsigned* xcnt = xb.bar + 3520 + 64 * (c & 7);
    unsigned* l1flag = xb.bar + 4032;
    if (lo == 0 && hi > 1) {
        if (local) {
            if ((c & 1) == 0) {
                phase_prologue(P, lds, 1, (c >> 3) * 4 + ((c & 7) >> 1), 128);
                asm volatile("s_waitcnt vmcnt(0)" ::: "memory");
                __syncthreads();
                if (threadIdx.x == 0) { __builtin_amdgcn_fence(__ATOMIC_RELEASE, "agent"); asm volatile("s_waitcnt vmcnt(0)" ::: "memory"); (void)xb_add(l1flag, 1u); }
            }
        } else { phase_prologue(P, lds, 1, (int)blockIdx.x, (int)gridDim.x); xcd_barrier(xb); }
    }
    PH(1, phase_proj(P, 0, lds, c))
    PHX(2, phase_s5(P, 0, lds, c, local))
    if (local && c >= 128) { group_arrive(xb, xcnt, 4); phase_glu(P, 0, lds, c, local); } else {
    PHX(3, phase_glu(P, 0, lds, c, local))
    }
    PHS(4, phase_merge(P, 0, lds, c))
    PHS(5, phase_out<0>(P, lds, c))
    if (local) { if (threadIdx.x == 0) { XB_SPIN(xb_ld(l1flag) < 128u, xb.bar); } __syncthreads(); }
    PHX(6, phase_proj(P, 1, lds, c))
    PHX(7, phase_s5(P, 1, lds, c, local))
    if (local && c >= 128) { group_arrive(xb, xcnt, 4); phase_glu(P, 1, lds, c, local); } else {
    PHX(8, phase_glu(P, 1, lds, c, local))
    }
    PHS(9, phase_merge(P, 1, lds, c))
    if (fuse_final) { seam_sync(xb, grp, local); phase_out_final(P, lds, xb, grp, local, c); }
    else {
    PH(10, phase_out<1>(P, lds, c))
    PH(11, phase_final(P))
    }
#undef PHX
#undef PHS
#undef PH
}

extern "C" void kernel_launch(void* const* d_in, const int* in_sizes, int n_in, void* d_out, int out_size, void* d_ws, size_t ws_size, hipStream_t stream) {
    static int grid = 0;
    if (grid == 0) {
        if (n_in != 20 || in_sizes[0] != T * DM || out_size != T * DM || ws_size < WS_END) { fprintf(stderr, "kernel_launch: unexpected shapes / workspace (%zu needed, %zu given)\n", (size_t)WS_END, ws_size); grid = -1; return; }
        int dev = 0, cus = 0, per_cu = 0;
        if (hipGetDevice(&dev) != hipSuccess || hipDeviceGetAttribute(&cus, hipDeviceAttributeMultiprocessorCount, dev) != hipSuccess) { grid = -1; return; }
        if (hipFuncSetAttribute((const void*)hawk_fwd, hipFuncAttributeMaxDynamicSharedMemorySize, LDS_BYTES) != hipSuccess) { fprintf(stderr, "kernel_launch: hipFuncSetAttribute failed\n"); grid = -1; return; }
        if (hipOccupancyMaxActiveBlocksPerMultiprocessor(&per_cu, (const void*)hawk_fwd, NTHR, LDS_BYTES) != hipSuccess || per_cu < 1) { fprintf(stderr, "kernel_launch: occupancy query reports %d\n", per_cu); (void)hipGetLastError(); }
        grid = cus;
    }
    if (grid < 0) return;
    (void)hipMemsetAsync((unsigned char*)d_ws + OFF_BAR, 0, 32768, stream);
    Params p{};
    const float** pp = (const float**)&p;
    for (int i = 0; i < 20; ++i) pp[i] = (const float*)d_in[i];
    p.out = (float*)d_out; p.ws = (unsigned char*)d_ws;
#if N_LAUNCH_MODE == 1
    p.ph_lo = 0; p.ph_hi = N_PHASES;
    hipLaunchKernelGGL(hawk_fwd, dim3(grid), dim3(NTHR), LDS_BYTES, stream, p);
#else
    for (int ph = 0; ph < N_PHASES; ++ph) { p.ph_lo = ph; p.ph_hi = ph + 1; hipLaunchKernelGGL(hawk_fwd, dim3(grid), dim3(NTHR), LDS_BYTES, stream, p); }
#endif
}
```

```cpp
#include <hip/hip_runtime.h>
#include <stdint.h>
#include <cstdio>

#ifndef N_LAUNCH_MODE
#define N_LAUNCH_MODE 1
#endif

typedef unsigned short bf16_t;
typedef short bf16x8 __attribute__((ext_vector_type(8)));
typedef float f32x4 __attribute__((ext_vector_type(4)));
typedef unsigned u32x4 __attribute__((ext_vector_type(4)));
typedef unsigned u32x2 __attribute__((ext_vector_type(2)));
#define LAS __attribute__((address_space(3)))

constexpr int T = 16384, DM = 1024, SEQ = 2048;
constexpr int QC = 16, QSH = 4;
constexpr int KI = QC * 16;
constexpr int KA = KI + 128;
constexpr int MG = T / QC;
constexpr int KTI = KI / 64;
constexpr float EPS = 1e-6f;

constexpr size_t OFF_BAR = 0;
constexpr size_t OFF_SS = 32768;
constexpr size_t OFF_AQ = OFF_SS + 3 * (size_t)T * 4;
constexpr size_t OFF_W = 262144;
constexpr size_t WL_WIN = 0, WL_WGLU = WL_WIN + 4096 * 1024 * 2, WL_POOL = WL_WGLU + 512 * 512 * 2, WL_WA = WL_POOL + 4 * 128 * 128 * 2,
                 WL_WB = WL_WA + 1024 * 512 * 2, WL_WOUT = WL_WB + 1024 * 512 * 2, WL_M13 = WL_WOUT + 1024 * 1024 * 2,
                 WL_M2 = WL_M13 + (size_t)32 * KI * KA * 2, WL_SIZE = WL_M2 + (size_t)32 * 128 * KI * 2;
constexpr size_t OFF_H = OFF_W + 2 * WL_SIZE;
constexpr size_t OFF_S = OFF_H + (size_t)T * 512 * 2;
constexpr size_t OFF_UAP = OFF_H + (size_t)T * 1024 * 2;

constexpr size_t OFF_ZA = OFF_UAP + (size_t)32 * MG * KA * 2;
constexpr size_t OFF_UB = OFF_ZA + (size_t)T * 512 * 2;

constexpr size_t OFF_ZB = OFF_UB + (size_t)T * 512 * 2;
constexpr size_t OFF_GA = OFF_ZB + (size_t)T * 512 * 2;
constexpr size_t OFF_GB = OFF_GA + (size_t)T * 1024 * 2;
constexpr size_t OFF_YA = OFF_ZA;
constexpr size_t OFF_YB = OFF_GB + (size_t)T * 1024 * 2;
constexpr size_t OFF_YPRE = OFF_YB + (size_t)T * 512 * 2;
constexpr size_t WS_END = OFF_YPRE + (size_t)T * 512 * 2;
constexpr int HALF_LDS = 67584;
constexpr int LDS_BYTES = 2 * HALF_LDS + 1024;
constexpr int LDS_XB = 2 * HALF_LDS;
constexpr int NTHR = 512;

struct Params {
    const float *x, *norm_g, *w_in, *b_in, *log_dt, *lam_re, *lam_im, *b_re, *b_im, *c_re, *c_im, *d_skip, *w_glu, *b_glu, *pool_w, *pool_scale, *w_a, *w_b, *w_out, *final_g;
    float* out; unsigned char* ws;
    int ph_lo, ph_hi;
};

__device__ __forceinline__ unsigned pk2(float lo, float hi) { unsigned r; asm("v_cvt_pk_bf16_f32 %0, %1, %2" : "=v"(r) : "v"(lo), "v"(hi)); return r; }
__device__ __forceinline__ float bf_lo(unsigned u) { return __uint_as_float(u << 16); }
__device__ __forceinline__ float bf_hi(unsigned u) { return __uint_as_float(u & 0xffff0000u); }
__device__ __forceinline__ float sigm(float x) { return __builtin_amdgcn_rcpf(1.f + __expf(-x)); }
__device__ __forceinline__ float silu(float x) { return x * sigm(x); }
__device__ __forceinline__ float gelu_tanh(float y) { return y * sigm(1.5957691216f * (y + 0.044715f * y * y * y)); }
__device__ __forceinline__ u32x2 pk4(f32x4 v) { u32x2 r; r.x = pk2(v.x, v.y); r.y = pk2(v.z, v.w); return r; }
__device__ __forceinline__ f32x4 unpk4(u32x2 u) { f32x4 r; r.x = bf_lo(u.x); r.y = bf_hi(u.x); r.z = bf_lo(u.y); r.w = bf_hi(u.y); return r; }
__device__ __forceinline__ u32x4 pk8(f32x4 a, f32x4 b) { u32x4 w; w.x = pk2(a.x, a.y); w.y = pk2(a.z, a.w); w.z = pk2(b.x, b.y); w.w = pk2(b.z, b.w); return w; }
__device__ __forceinline__ void unpk8(u32x4 w, f32x4& a, f32x4& b) { a.x = bf_lo(w.x); a.y = bf_hi(w.x); a.z = bf_lo(w.y); a.w = bf_hi(w.y); b.x = bf_lo(w.z); b.y = bf_hi(w.z); b.z = bf_lo(w.w); b.w = bf_hi(w.w); }

#define XB_TMO      128
#define XB_XCNT(j)  (256  + 64 * (j))
#define XB_XSUB(j)  (1280 + 64 * (j))
#define XB_XGEN(j)  (2304 + 64 * (j))
#define XB_TOP      3328
#define XB_TOPGEN   3392
#define XCD_BAR_WORDS 3456
#define XB_SPIN_CAP (1u << 20)
__device__ __forceinline__ unsigned xb_ld(unsigned* p)              { return __hip_atomic_load(p, __ATOMIC_RELAXED, __HIP_MEMORY_SCOPE_AGENT); }
__device__ __forceinline__ unsigned xb_add(unsigned* p, unsigned v) { return __hip_atomic_fetch_add(p, v, __ATOMIC_RELAXED, __HIP_MEMORY_SCOPE_AGENT); }
__device__ __forceinline__ unsigned xb_xcc_id() { return (unsigned)__builtin_amdgcn_s_getreg((3 << 11) | 20) & 0xFu; }
#define XB_SPIN(cond, bar) do { unsigned _sp = 0; while (cond) { __builtin_amdgcn_s_sleep(1); \
    if ((++_sp & 255u) == 0u) { if (xb_ld(&(bar)[XB_TMO])) break; if (_sp > XB_SPIN_CAP) { atomicAdd(&(bar)[XB_TMO], 1u); break; } } } } while (0)
struct XcdBarrier { unsigned* bar; unsigned x; volatile LAS unsigned* st; };
__device__ __forceinline__ XcdBarrier xcd_barrier_post(unsigned* bar, volatile LAS unsigned* st) {
    XcdBarrier b; b.bar = bar; b.x = xb_xcc_id(); b.st = st;
    if (threadIdx.x == 0) st[2] = xb_add(&bar[XB_XCNT(b.x)], 1u);
    return b;
}
__device__ __forceinline__ void xcd_barrier_complete(unsigned* bar, unsigned x, unsigned& nloc, unsigned& nx) {
    const unsigned G = gridDim.x * gridDim.y * gridDim.z;
    unsigned sum, cnt, mine, sp = 0u;
    for (;;) {
        sum = 0u; cnt = 0u; mine = 0u;
#pragma unroll
        for (unsigned j = 0; j < 16; ++j) { const unsigned c = xb_ld(&bar[XB_XCNT(j)]); sum += c; cnt += (c > 0u) ? 1u : 0u; mine = (j == x) ? c : mine; }
        if (sum == G) break;
        __builtin_amdgcn_s_sleep(1);
        if ((++sp & 255u) == 0u) { if (xb_ld(&bar[XB_TMO])) break; if (sp > XB_SPIN_CAP) { atomicAdd(&bar[XB_TMO], 1u); break; } }
    }
    nloc = mine > 0u ? mine : 1u; nx = cnt > 0u ? cnt : 1u;
}
__device__ __forceinline__ void xcd_barrier(const XcdBarrier& b) {
    asm volatile("s_waitcnt vmcnt(0)" ::: "memory");
    __syncthreads();
    if (threadIdx.x == 0) {
        unsigned* bar = b.bar;
        __builtin_amdgcn_s_waitcnt(0);
        unsigned nloc = b.st[0], nx = b.st[1];
        if (nloc == 0u) { xcd_barrier_complete(bar, b.x, nloc, nx); b.st[0] = nloc; b.st[1] = nx; }
        const unsigned old = xb_add(&bar[XB_XSUB(b.x)], 1u);
        const unsigned gen = old / nloc;
        if (old + 1u == (gen + 1u) * nloc) {
            __builtin_amdgcn_fence(__ATOMIC_RELEASE, "agent");
            asm volatile("s_waitcnt vmcnt(0)" ::: "memory");
            const unsigned og = xb_add(&bar[XB_TOP], 1u);
            const unsigned tg = og / nx;
            if (og + 1u == (tg + 1u) * nx) xb_add(&bar[XB_TOPGEN], 1u);
            else XB_SPIN(xb_ld(&bar[XB_TOPGEN]) == tg, bar);
            __builtin_amdgcn_fence(__ATOMIC_ACQUIRE, "agent");
            xb_add(&bar[XB_XGEN(b.x)], 1u);
            asm volatile("s_waitcnt vmcnt(0)" ::: "memory");
        } else {
            XB_SPIN(xb_ld(&bar[XB_XGEN(b.x)]) == gen, bar);
            __builtin_amdgcn_fence(__ATOMIC_ACQUIRE, "agent");
            asm volatile("s_waitcnt vmcnt(0)" ::: "memory");
        }
    }
    __syncthreads();
}

__device__ __forceinline__ void group_barrier(const XcdBarrier& b, unsigned* grp, unsigned n = 4u, int slot = 3) {
    asm volatile("s_waitcnt vmcnt(0)" ::: "memory");
    __syncthreads();
    if (threadIdx.x == 0) {
        __builtin_amdgcn_s_waitcnt(0);
        const unsigned k = b.st[slot] + 1u; b.st[slot] = k;
        (void)xb_add(grp, 1u);
        const unsigned target = n * k;
        XB_SPIN(xb_ld(grp) < target, b.bar);
        __builtin_amdgcn_fence(__ATOMIC_ACQUIRE, "agent");
        asm volatile("s_waitcnt vmcnt(0)" ::: "memory");
    }
    __syncthreads();
}
__device__ __forceinline__ void group_arrive(const XcdBarrier& b, unsigned* grp, int slot) {
    asm volatile("s_waitcnt vmcnt(0)" ::: "memory");
    __syncthreads();
    if (threadIdx.x == 0) { b.st[slot] = b.st[slot] + 1u; (void)xb_add(grp, 1u); }
    __syncthreads();
}
__device__ __forceinline__ void seam_sync(const XcdBarrier& b, unsigned* grp, bool local) { if (local) group_barrier(b, grp); else xcd_barrier(b); }
__device__ __forceinline__ void seam_sync_xcc(const XcdBarrier& b, unsigned* xcnt, bool local) { if (local) group_barrier(b, xcnt, 32u, 4); else xcd_barrier(b); }

struct LoadPlain { const bf16_t* base; int ld;
    __device__ __forceinline__ bf16x8 operator()(int r, int kc) const { return *(const bf16x8*)(base + (size_t)r * ld + kc * 8); } };
struct LoadRemap { const bf16_t* base; int ld; int nk1;
    __device__ __forceinline__ bf16x8 operator()(int r, int kc) const { int kt = kc >> 3; if (kt >= nk1) kt += KTI - nk1; return *(const bf16x8*)(base + (size_t)r * ld + kt * 64 + (kc & 7) * 8); } };
struct LoadPool { const bf16_t* ub; int row0; int pg;
    __device__ __forceinline__ bf16x8 operator()(int r, int kc) const {
        const int t = row0 + r, pos = t & (SEQ - 1), win = 2 << pg, cnt = (pos + 1) < win ? (pos + 1) : win;
        const bf16_t* p = ub + (size_t)t * 512 + pg * 128 + kc * 8;
        const u32x4 c = *(const u32x4*)p;
        float s0 = bf_lo(c.x), s1 = bf_hi(c.x), s2 = bf_lo(c.y), s3 = bf_hi(c.y), s4 = bf_lo(c.z), s5 = bf_hi(c.z), s6 = bf_lo(c.w), s7 = bf_hi(c.w);
        const float c0 = s0, c1 = s1, c2 = s2, c3 = s3, c4 = s4, c5 = s5, c6 = s6, c7 = s7;
        for (int j = 1; j < cnt; ++j) { const u32x4 v = *(const u32x4*)(p - (size_t)j * 512);
            s0 += bf_lo(v.x); s1 += bf_hi(v.x); s2 += bf_lo(v.y); s3 += bf_hi(v.y); s4 += bf_lo(v.z); s5 += bf_hi(v.z); s6 += bf_lo(v.w); s7 += bf_hi(v.w); }
        const float ic = 1.f / (float)cnt;
        u32x4 o; o.x = pk2(s0 * ic - c0, s1 * ic - c1); o.y = pk2(s2 * ic - c2, s3 * ic - c3); o.z = pk2(s4 * ic - c4, s5 * ic - c5); o.w = pk2(s6 * ic - c6, s7 * ic - c7);
        return __builtin_bit_cast(bf16x8, o);
    } };

__device__ __forceinline__ void mma_ktile(f32x4 (&acc)[4][4], const unsigned char* cur, int tid) {
    const int lane = tid & 63, wid = tid >> 6, wr = wid >> 1, wc = wid & 1, fr = lane & 15, fq = lane >> 4;
    const int rd_a = (wr * 64 + fr) * 128, rd_b = 16384 + (wc * 64 + fr) * 128;
    const int sw0 = ((fq ^ (fr & 7)) << 4), sw1 = (((4 + fq) ^ (fr & 7)) << 4);
#pragma unroll
    for (int s = 0; s < 2; ++s) {
        const int sw = s ? sw1 : sw0;
        bf16x8 af[4], bf[4];
#pragma unroll
        for (int i = 0; i < 4; ++i) af[i] = *(const bf16x8*)(cur + rd_a + i * 2048 + sw);
#pragma unroll
        for (int j = 0; j < 4; ++j) bf[j] = *(const bf16x8*)(cur + rd_b + j * 2048 + sw);
#pragma unroll
        for (int i = 0; i < 4; ++i)
#pragma unroll
            for (int j = 0; j < 4; ++j) acc[i][j] = __builtin_amdgcn_mfma_f32_16x16x32_bf16(bf[j], af[i], acc[i][j], 0, 0, 0);
    }
}
template <class AL, class BL>
__device__ __forceinline__ void gemm_mainloop(f32x4 (&acc)[4][4], const AL& al, const BL& bl, const int nkt, unsigned char* lds) {
    int tid = threadIdx.x & 255; asm volatile("" : "+v"(tid));
    const int lr = tid >> 3, lc = tid & 7;
    const int st_off = lr * 128 + ((lc ^ (lr & 7)) << 4);
    bf16x8 a0[4], b0[4], a1[4], b1[4], a2[4], b2[4];
#define GM_LOAD(A, B, KT) do { _Pragma("unroll") for (int i = 0; i < 4; ++i) { A[i] = al(lr + 32 * i, (KT) * 8 + lc); B[i] = bl(lr + 32 * i, (KT) * 8 + lc); } } while (0)
#define GM_STORE(A, B, BUF) do { _Pragma("unroll") for (int i = 0; i < 4; ++i) { *(bf16x8*)((BUF) + st_off + i * 4096) = A[i]; *(bf16x8*)((BUF) + 16384 + st_off + i * 4096) = B[i]; } } while (0)
#define GM_STEP(KT, LA, LB, SA, SB) do { const int _kt = (KT); if (_kt < nkt) { \
        if (_kt + 3 < nkt) GM_LOAD(LA, LB, _kt + 3); \
        mma_ktile(acc, lds + (_kt & 1) * 32768, tid); \
        if (_kt + 1 < nkt) GM_STORE(SA, SB, lds + ((_kt + 1) & 1) * 32768); \
        __syncthreads(); } } while (0)
    GM_LOAD(a0, b0, 0);
    if (nkt > 1) GM_LOAD(a1, b1, 1);
    if (nkt > 2) GM_LOAD(a2, b2, 2);
    GM_STORE(a0, b0, lds);
    __syncthreads();
#pragma unroll 1
    for (int kt = 0; kt < nkt; kt += 3) {
        GM_STEP(kt, a0, b0, a1, b1);
        GM_STEP(kt + 1, a1, b1, a2, b2);
        GM_STEP(kt + 2, a2, b2, a0, b0);
    }
#undef GM_LOAD
#undef GM_STORE
#undef GM_STEP
}
__device__ __forceinline__ void zero_acc(f32x4 (&acc)[4][4]) {
#pragma unroll
    for (int i = 0; i < 4; ++i)
#pragma unroll
        for (int j = 0; j < 4; ++j) acc[i][j] = (f32x4){0.f, 0.f, 0.f, 0.f};
}
#define EPI_LOOP(...) do { int _t = threadIdx.x & 255; asm volatile("" : "+v"(_t)); const int _l = _t & 63, _w = _t >> 6, _wr = _w >> 1, _wc = _w & 1, _fr = _l & 15, _fq = _l >> 4; \
    _Pragma("unroll") for (int i = 0; i < 4; ++i) _Pragma("unroll") for (int j = 0; j < 4; ++j) { const int m = _wr * 64 + i * 16 + _fr, n = _wc * 64 + j * 16 + _fq * 4; f32x4& v = acc[i][j]; __VA_ARGS__ } } while (0)


#define ADD8(S, V, SGN) do { S[0] += SGN bf_lo(V.x); S[1] += SGN bf_hi(V.x); S[2] += SGN bf_lo(V.y); S[3] += SGN bf_hi(V.y); S[4] += SGN bf_lo(V.z); S[5] += SGN bf_hi(V.z); S[6] += SGN bf_lo(V.w); S[7] += SGN bf_hi(V.w); } while (0)
__device__ __forceinline__ void pool_tile(f32x4 (&acc)[4][4], const bf16_t* UB, const bf16_t* Wt, const bf16_t* ZB, u32x2 (&zz)[4][4], int row0, int pg, unsigned char* lds) {
    int tid = threadIdx.x & 255; asm volatile("" : "+v"(tid));
    const int c16 = tid & 15, r0 = (tid >> 4) * 8, kt = c16 >> 3, lc = c16 & 7;
    const int t0 = row0 + r0, pos0 = t0 & (SEQ - 1), win = 2 << pg;
    const bf16_t* p = UB + (size_t)t0 * 512 + pg * 128 + c16 * 8;
    float s[8];
#pragma unroll
    for (int e = 0; e < 8; ++e) s[e] = 0.f;
#define GLD16(dst, ptr) asm volatile("global_load_dwordx4 %0, %1, off" : "=v"(dst) : "v"(ptr) : "memory")
#define GLD8(dst, ptr) asm volatile("global_load_dwordx2 %0, %1, off" : "=v"(dst) : "v"(ptr) : "memory")
#define PIN4(a, b, c, d) asm volatile("" : "+v"(a), "+v"(b), "+v"(c), "+v"(d) :: "memory")
    u32x4 wv[8], pre[15], cur[8], old[8];
#pragma unroll
    for (int i = 0; i < 8; ++i) { const bf16_t* q = Wt + (size_t)((tid >> 4) + 16 * i) * 128 + c16 * 8; GLD16(wv[i], q); }
#pragma unroll
    for (int j = 1; j < 16; ++j) { const bool ok = (j < win) && (pos0 >= j); const bf16_t* q = p - (size_t)(ok ? j : 0) * 512; GLD16(pre[j - 1], q); }
#pragma unroll
    for (int i = 0; i < 8; ++i) { const bf16_t* q = p + (size_t)i * 512; GLD16(cur[i], q);
        const int jo = i - win + 1; const bool ok = (pos0 + jo >= 0); const bf16_t* q2 = p + (long)(ok ? jo : 0) * 512; GLD16(old[i], q2); }
    asm volatile("s_waitcnt vmcnt(0)" : "+v"(pre[0]), "+v"(pre[1]), "+v"(pre[2]), "+v"(pre[3]) :: "memory");
    PIN4(pre[4], pre[5], pre[6], pre[7]); PIN4(pre[8], pre[9], pre[10], pre[11]); PIN4(pre[12], pre[13], pre[14], cur[0]);
    PIN4(cur[1], cur[2], cur[3], cur[4]); PIN4(cur[5], cur[6], cur[7], old[0]); PIN4(old[1], old[2], old[3], old[4]); PIN4(old[5], old[6], old[7], wv[0]);
    PIN4(wv[1], wv[2], wv[3], wv[4]); PIN4(wv[5], wv[6], wv[7], wv[0]);
#pragma unroll
    for (int j = 1; j < 16; ++j) { const bool ok = (j < win) && (pos0 >= j); if (!ok) pre[j - 1] = (u32x4){0u, 0u, 0u, 0u}; }
#pragma unroll
    for (int i = 0; i < 8; ++i) { const bool ok = (pos0 + i - win + 1 >= 0); if (!ok) old[i] = (u32x4){0u, 0u, 0u, 0u}; }
#pragma unroll
    for (int j = 0; j < 15; ++j) ADD8(s, pre[j], +);
#pragma unroll
    for (int i = 0; i < 8; ++i) {
        const u32x4 c = cur[i]; ADD8(s, c, +);
        const int pos = pos0 + i, cnt = (pos + 1) < win ? (pos + 1) : win; const float ic = 1.f / (float)cnt;
        u32x4 o; o.x = pk2(s[0] * ic - bf_lo(c.x), s[1] * ic - bf_hi(c.x)); o.y = pk2(s[2] * ic - bf_lo(c.y), s[3] * ic - bf_hi(c.y));
        o.z = pk2(s[4] * ic - bf_lo(c.z), s[5] * ic - bf_hi(c.z)); o.w = pk2(s[6] * ic - bf_lo(c.w), s[7] * ic - bf_hi(c.w));
        const int r = r0 + i;
        *(u32x4*)(lds + kt * 32768 + r * 128 + ((lc ^ (r & 7)) << 4)) = o;
        ADD8(s, old[i], -);
    }
#pragma unroll
    for (int i = 0; i < 8; ++i) { const int r = (tid >> 4) + 16 * i; *(u32x4*)(lds + kt * 32768 + 16384 + r * 128 + ((lc ^ (r & 7)) << 4)) = wv[i]; }
    {
        const int lane = tid & 63, w = tid >> 6, wr = w >> 1, wc = w & 1, fr = lane & 15, fq = lane >> 4;
#pragma unroll
        for (int i = 0; i < 4; ++i)
#pragma unroll
            for (int j = 0; j < 4; ++j) { const bf16_t* q = ZB + (size_t)(row0 + wr * 64 + i * 16 + fr) * 512 + pg * 128 + wc * 64 + j * 16 + fq * 4; GLD8(zz[i][j], q); }
    }
    __syncthreads();
    mma_ktile(acc, lds, tid); mma_ktile(acc, lds + 32768, tid);
    asm volatile("s_waitcnt vmcnt(0)" : "+v"(zz[0][0]), "+v"(zz[0][1]), "+v"(zz[0][2]), "+v"(zz[0][3]) :: "memory");
    PIN4(zz[1][0], zz[1][1], zz[1][2], zz[1][3]); PIN4(zz[2][0], zz[2][1], zz[2][2], zz[2][3]); PIN4(zz[3][0], zz[3][1], zz[3][2], zz[3][3]);
    __syncthreads();
}

namespace pg8 {
#define PG8_LAS __attribute__((address_space(3)))
typedef unsigned short bf16_t;
typedef short bf16x8 __attribute__((ext_vector_type(8)));
typedef float f32x4 __attribute__((ext_vector_type(4)));
typedef unsigned u32x4 __attribute__((ext_vector_type(4)));
constexpr int BM = 256, BK = 64, HALF = 128, HTB = HALF * BK * 2  , STAGE_BYTES = 8 * HTB, NXCD = 8, WGM = 8;

__host__ __device__ __forceinline__ int lds_byte(int r, int c) { const int st = (r >> 4) * 2 + (c >> 5), rr = r & 15, cc = c & 31, ob = rr * 64 + cc * 2; return st * 1024 + (ob ^ (((ob >> 9) & 1) << 5)); }
__host__ __device__ __forceinline__ void stage_rc(int b, int& R, int& C) { const int st = b / 1024, sb = b % 1024, swz = sb ^ (((sb >> 9) & 1) << 5); R = (st >> 1) * 16 + swz / 64; C = (st & 1) * 32 + (swz % 64) / 2; }
__host__ __device__ __forceinline__ int perm32(int rho) { const int n = rho >> 4, i = rho & 15; return 8 * (i >> 2) + 4 * n + (i & 3); }

struct Unit { int pm, pn; };
struct Gemm { const bf16_t* A; const bf16_t* Bt; int M, N, K; };

struct StaticOrder {
    int nM, nN, nwg, G, c;
    __host__ __device__ void init(int M, int N, int G_, int c_) { nM = M / BM; nN = N / BM; nwg = nM * nN; G = G_; c = c_; }
    __host__ __device__ bool next(int i, Unit& u) const {
        const long L = (long)i * G + c; if (L >= nwg) return false;
        int wgid = (int)L; { const int q = nwg / NXCD, r = nwg % NXCD, xcd = wgid % NXCD, off = wgid / NXCD; wgid = (xcd < r ? xcd * (q + 1) : r * (q + 1) + (xcd - r) * q) + off; }
        const int nig = WGM * nN, gid = wgid / nig, fm = gid * WGM, gsz = (nM - fm) < WGM ? (nM - fm) : WGM;
        u.pm = fm + ((wgid % nig) % gsz); u.pn = (wgid % nig) / gsz; return true;
    }
    __device__ __forceinline__ void a_ready(const Unit&) const {}
    __device__ __forceinline__ void done(const Unit&) const {}
};

__device__ __forceinline__ unsigned cvt_pk_bf16(float lo, float hi) { unsigned r; asm volatile("v_cvt_pk_bf16_f32 %0, %1, %2" : "=v"(r) : "v"(lo), "v"(hi)); return r; }

template <class Epi, class Sched, bool ALIGN_EPI = false, bool SP2 = false>
__device__ __forceinline__ void gemm_phase(PG8_LAS unsigned char* lds, const Gemm g, const Sched& S, const Epi& E) {
    const int tid = threadIdx.x, wid = __builtin_amdgcn_readfirstlane(tid >> 6), lane = tid & 63, wr = wid >> 2, wc = wid & 3, fr = lane & 15, fq = lane >> 4;
    const int K = g.K, nt = K / BK;
    unsigned voffA[2], voffB[2];
#pragma unroll
    for (int i = 0; i < 2; ++i) { int R, C; stage_rc(tid * 16 + i * 8192, R, C); const int Rb = Epi::PERM ? ((R & ~31) + perm32(R & 31)) : R;
        voffA[i] = (unsigned)(R * K + C) * 2u; voffB[i] = (unsigned)(Rb * K + C) * 2u; }
    const size_t kstep = (size_t)(BK * 2);
    const size_t hstep = (size_t)HALF * K * 2;
    const size_t tstep = 2 * hstep;
    const unsigned ldsw = (unsigned)wid * 1024u;
    const int aoff = lds_byte(wr * 64 + fr, fq * 8), boff = lds_byte(wc * 32 + fr, fq * 8);
#define PG8_SA(b, h) (((b) * 2 + (h)) * HTB)
#define PG8_SB(b, h) ((4 + (b) * 2 + (h)) * HTB)
#define PG8_STAGE(bufoff, gbase, voff) do { _Pragma("unroll") for (int _i = 0; _i < 2; ++_i) \
        __builtin_amdgcn_global_load_lds((const unsigned*)((const char*)(gbase) + (voff)[_i]), (PG8_LAS unsigned*)(lds + (bufoff) + ldsw + _i * 8192), 16, 0, 0); } while (0)
#define PG8_LDA(dst, b, h) do { _Pragma("unroll") for (int m = 0; m < 4; ++m) _Pragma("unroll") for (int k = 0; k < 2; ++k) dst[m][k] = *(const PG8_LAS bf16x8*)(lds + PG8_SA(b, h) + aoff + m * 2048 + k * 1024); } while (0)
#define PG8_LDB(dst, b, h) do { _Pragma("unroll") for (int n = 0; n < 2; ++n) _Pragma("unroll") for (int k = 0; k < 2; ++k) dst[n][k] = *(const PG8_LAS bf16x8*)(lds + PG8_SB(b, h) + boff + n * 2048 + k * 1024); } while (0)
#define PG8_MMA(ai, bj, At, Bt) do { __builtin_amdgcn_s_setprio(1); _Pragma("unroll") for (int m = 0; m < 4; ++m) _Pragma("unroll") for (int n = 0; n < 2; ++n) _Pragma("unroll") for (int k = 0; k < 2; ++k) \
        acc[ai][bj][m][n] = __builtin_amdgcn_mfma_f32_16x16x32_bf16(Bt[n][k], At[m][k], acc[ai][bj][m][n], 0, 0, 0); __builtin_amdgcn_s_setprio(0); } while (0)
#define PG8_WAIT_V(n) asm volatile("s_waitcnt vmcnt(" #n ")" ::: "memory")
#define PG8_WAIT_L(n) asm volatile("s_waitcnt lgkmcnt(" #n ")" ::: "memory")
#define PG8_BAR __builtin_amdgcn_s_barrier()
#define PG8_SCHED __builtin_amdgcn_sched_barrier(0)
    Unit cur, nxt; int ui = 0;
    if (!S.next(0, cur)) return;
    f32x4 acc[2][2][4][2];
#pragma unroll
    for (int a = 0; a < 2; ++a)
#pragma unroll
        for (int b = 0; b < 2; ++b)
#pragma unroll
            for (int m = 0; m < 4; ++m)
#pragma unroll
                for (int n = 0; n < 2; ++n) acc[a][b][m][n] = (f32x4){0.f, 0.f, 0.f, 0.f};
    bf16x8 At[4][2], B0[2][2], B1[2][2];
    const char* cA = (const char*)g.A + (size_t)cur.pm * tstep; const char* cB = (const char*)g.Bt + (size_t)cur.pn * tstep;
    S.a_ready(cur);
    if constexpr (SP2) {
        PG8_STAGE(PG8_SB(0, 0), cB, voffB); PG8_STAGE(PG8_SB(0, 1), cB + hstep, voffB); PG8_STAGE(PG8_SA(0, 0), cA, voffA); PG8_STAGE(PG8_SA(0, 1), cA + hstep, voffA);
        if (wr == 1) PG8_BAR;
        PG8_WAIT_V(2); PG8_BAR;
        PG8_STAGE(PG8_SB(1, 0), cB + kstep, voffB); PG8_STAGE(PG8_SA(1, 0), cA + kstep, voffA); PG8_STAGE(PG8_SB(1, 1), cB + hstep + kstep, voffB);
        PG8_WAIT_V(6); PG8_BAR;
    } else {
        PG8_STAGE(PG8_SB(0, 0), cB, voffB); PG8_STAGE(PG8_SA(0, 0), cA, voffA); PG8_STAGE(PG8_SB(0, 1), cB + hstep, voffB); PG8_STAGE(PG8_SA(0, 1), cA + hstep, voffA);
        if (wr == 1) PG8_BAR;
        PG8_WAIT_V(4); PG8_BAR;
        PG8_STAGE(PG8_SB(1, 0), cB + kstep, voffB); PG8_STAGE(PG8_SA(1, 0), cA + kstep, voffA); PG8_STAGE(PG8_SB(1, 1), cB + hstep + kstep, voffB);
        PG8_WAIT_V(6); PG8_BAR;
    }
    for (;;) {
        const bool has_next = S.next(ui + 1, nxt);
        const char* nA = has_next ? (const char*)g.A + (size_t)nxt.pm * tstep : cA; const char* nB = has_next ? (const char*)g.Bt + (size_t)nxt.pn * tstep : cB;
        for (int t = 0; t < nt; t += 2) {
            const bool last = (t == nt - 2);
            const char* a1 = cA + (size_t)(t + 1) * kstep;
            const char* a2 = last ? nA : cA + (size_t)(t + 2) * kstep; const char* b2 = last ? nB : cB + (size_t)(t + 2) * kstep;
            const char* a3 = a2 + kstep; const char* b3 = b2 + kstep;
            if (last && has_next) S.a_ready(nxt);
            if constexpr (SP2) {
            PG8_LDB(B0, 0, 0); PG8_LDB(B1, 0, 1); PG8_SCHED; PG8_LDA(At, 0, 0); PG8_STAGE(PG8_SA(1, 1), a1 + hstep, voffA);
            PG8_WAIT_V(8); PG8_WAIT_L(0); PG8_BAR; PG8_MMA(0, 0, At, B0); PG8_MMA(0, 1, At, B1); PG8_BAR; PG8_SCHED;
            PG8_LDA(At, 0, 1); PG8_STAGE(PG8_SB(0, 0), b2, voffB); PG8_STAGE(PG8_SB(0, 1), b2 + hstep, voffB); PG8_STAGE(PG8_SA(0, 0), a2, voffA);
            PG8_WAIT_V(8); PG8_WAIT_L(0); PG8_BAR; PG8_MMA(1, 0, At, B0); PG8_MMA(1, 1, At, B1); PG8_BAR; PG8_SCHED;
            PG8_LDB(B0, 1, 0); PG8_LDB(B1, 1, 1); PG8_SCHED; PG8_LDA(At, 1, 0); PG8_STAGE(PG8_SA(0, 1), a2 + hstep, voffA);
            PG8_WAIT_V(8); PG8_WAIT_L(0); PG8_BAR; PG8_MMA(0, 0, At, B0); PG8_MMA(0, 1, At, B1); PG8_BAR; PG8_SCHED;
            PG8_LDA(At, 1, 1); PG8_STAGE(PG8_SB(1, 0), b3, voffB); PG8_STAGE(PG8_SB(1, 1), b3 + hstep, voffB); PG8_STAGE(PG8_SA(1, 0), a3, voffA);
            PG8_WAIT_V(8); PG8_WAIT_L(0); PG8_BAR; PG8_MMA(1, 0, At, B0); PG8_MMA(1, 1, At, B1); PG8_BAR; PG8_SCHED;
            } else {
            PG8_LDB(B0, 0, 0); PG8_SCHED; PG8_LDA(At, 0, 0); PG8_STAGE(PG8_SA(1, 1), a1 + hstep, voffA);
            PG8_WAIT_L(8); PG8_BAR; PG8_WAIT_L(0); PG8_MMA(0, 0, At, B0); PG8_BAR; PG8_SCHED;
            PG8_LDB(B1, 0, 1); PG8_STAGE(PG8_SB(0, 0), b2, voffB);
            PG8_BAR; PG8_WAIT_L(0); PG8_MMA(0, 1, At, B1); PG8_BAR;
            PG8_LDA(At, 0, 1); PG8_STAGE(PG8_SA(0, 0), a2, voffA);
            PG8_BAR; PG8_WAIT_L(0); PG8_MMA(1, 0, At, B0); PG8_BAR; PG8_SCHED;
            PG8_STAGE(PG8_SB(0, 1), b2 + hstep, voffB);
            PG8_WAIT_V(6); PG8_BAR; PG8_MMA(1, 1, At, B1); PG8_BAR;
            PG8_LDB(B0, 1, 0); PG8_SCHED; PG8_LDA(At, 1, 0); PG8_STAGE(PG8_SA(0, 1), a2 + hstep, voffA);
            PG8_WAIT_L(8); PG8_BAR; PG8_WAIT_L(0); PG8_MMA(0, 0, At, B0); PG8_BAR; PG8_SCHED;
            PG8_LDB(B1, 1, 1); PG8_STAGE(PG8_SB(1, 0), b3, voffB);
            PG8_BAR; PG8_WAIT_L(0); PG8_MMA(0, 1, At, B1); PG8_BAR;
            PG8_LDA(At, 1, 1); PG8_STAGE(PG8_SA(1, 0), a3, voffA);
            PG8_BAR; PG8_WAIT_L(0); PG8_MMA(1, 0, At, B0); PG8_BAR; PG8_SCHED;
            PG8_STAGE(PG8_SB(1, 1), b3 + hstep, voffB);
            PG8_WAIT_V(6); PG8_BAR; PG8_MMA(1, 1, At, B1); PG8_BAR;
            }
        }
        if constexpr (ALIGN_EPI) { if (wr == 0) PG8_BAR; }
        if constexpr (!Epi::AFTER_DRAIN) { E(acc, cur, wr, wc, fr, fq); S.done(cur); }
        if (!has_next) break;
#pragma unroll
        for (int a = 0; a < 2; ++a)
#pragma unroll
            for (int b = 0; b < 2; ++b)
#pragma unroll
                for (int m = 0; m < 4; ++m)
#pragma unroll
                    for (int n = 0; n < 2; ++n) acc[a][b][m][n] = (f32x4){0.f, 0.f, 0.f, 0.f};
        cur = nxt; cA = nA; cB = nB; ++ui;
        if constexpr (ALIGN_EPI) { if (wr == 1) PG8_BAR; }
    }
    PG8_WAIT_V(0);
    if constexpr (!ALIGN_EPI) { if (wr == 0) PG8_BAR; }
    PG8_BAR;
    if constexpr (Epi::AFTER_DRAIN) { E.fused(acc, cur, wr, wc, fr, fq, lds, wid, lane); S.done(cur); }
#undef PG8_SA
#undef PG8_SB
#undef PG8_STAGE
#undef PG8_LDA
#undef PG8_LDB
#undef PG8_MMA
#undef PG8_WAIT_V
#undef PG8_WAIT_L
#undef PG8_BAR
#undef PG8_SCHED
}
}

__device__ __forceinline__ void transpose_load(const float* __restrict__ src, int N, int k0, int n0, float* tile, int tid) {
#pragma unroll
    for (int i = 0; i < 4; ++i) { const int k = (tid >> 4) + 16 * i, n4 = (tid & 15) * 4;
        const f32x4 v = *(const f32x4*)(src + (size_t)(k0 + k) * N + n0 + n4);
        tile[k * 65 + n4] = v.x; tile[k * 65 + n4 + 1] = v.y; tile[k * 65 + n4 + 2] = v.z; tile[k * 65 + n4 + 3] = v.w; }
}
__device__ __forceinline__ void transpose_store(bf16_t* __restrict__ dst, int K, int k0, int n0, const float* tile, int tid) {
#pragma unroll
    for (int i = 0; i < 2; ++i) { const int n = (tid >> 3) + 32 * i, kc = (tid & 7) * 8; const float* s = tile + kc * 65 + n;
        u32x4 o; o.x = pk2(s[0], s[65]); o.y = pk2(s[2 * 65], s[3 * 65]); o.z = pk2(s[4 * 65], s[5 * 65]); o.w = pk2(s[6 * 65], s[7 * 65]);
        *(u32x4*)(dst + (size_t)(n0 + n) * K + k0 + kc) = o; }
}
__device__ __forceinline__ void ssm_tables_item(const Params& P, int item, unsigned char* lds) {
    const int tid = threadIdx.x, l = item >> 7, g = (item >> 2) & 31, tq = item & 3, lg = l * 32 + g;
    constexpr int PS = 36;
    float* pwr = (float*)lds;
    float* pwi = pwr + 64 * PS;
    float* bbr = pwi + 64 * PS;
    float* bbi = bbr + 1024;
    float* ccr = bbi + 1024;
    float* cci = ccr + 1024;
    float* cf = cci + 1024;
    float* ktab = cf + 128;
    unsigned char* wl = P.ws + OFF_W + (size_t)l * WL_SIZE;
    bf16_t* M13 = (bf16_t*)(wl + WL_M13) + (size_t)g * KI * KA;
    bf16_t* M2 = (bf16_t*)(wl + WL_M2) + (size_t)g * 128 * KI;
    if (tid < 64) {
        const int p = tid;
        const double dt = exp((double)P.log_dt[lg]);
        const double lr = (double)P.lam_re[lg * 64 + p], li = (double)P.lam_im[lg * 64 + p];
        const double mag = exp(lr * dt), ang = li * dt;
        const double ar = mag * cos(ang), ai = mag * sin(ang);
        const double nr = ar - 1.0, ni = ai, den = lr * lr + li * li;
        cf[2 * p] = (float)((nr * lr + ni * li) / den); cf[2 * p + 1] = (float)((ni * lr - nr * li) / den);
        double pr = 1.0, pi = 0.0;
        for (int k = 0; k <= QC; ++k) { pwr[p * PS + k] = (float)pr; pwi[p * PS + k] = (float)pi; const double t = pr * ar - pi * ai; pi = pr * ai + pi * ar; pr = t; }
    }
    for (int i = tid; i < 1024; i += NTHR) { ccr[i] = P.c_re[(size_t)lg * 1024 + i]; cci[i] = P.c_im[(size_t)lg * 1024 + i]; }
    __syncthreads();
    for (int i = tid; i < 1024; i += NTHR) { const int p = i >> 4; const float br = P.b_re[(size_t)lg * 1024 + i], bi = P.b_im[(size_t)lg * 1024 + i], cr = cf[2 * p], ci = cf[2 * p + 1];
        bbr[i] = cr * br - ci * bi; bbi[i] = cr * bi + ci * br; }
    __syncthreads();
    {
        const int co = (tid >> 4) & 15, ci = tid & 15, kh = tid >> 8;
        f32x4 a[2];
#pragma unroll
        for (int q = 0; q < 2; ++q) a[q] = (f32x4){0.f, 0.f, 0.f, 0.f};
        for (int p = 0; p < 64; ++p) {
            const float xr = ccr[co * 64 + p], xi = cci[co * 64 + p], yr = bbr[p * 16 + ci], yi = bbi[p * 16 + ci];
            const float cbr = xr * yr - xi * yi, cbi = xr * yi + xi * yr;
#pragma unroll
            for (int q = 0; q < 2; ++q) a[q] += cbr * *(const f32x4*)(pwr + p * PS + kh * 8 + q * 4) - cbi * *(const f32x4*)(pwi + p * PS + kh * 8 + q * 4);
        }
#pragma unroll
        for (int q = 0; q < 2; ++q) { ktab[(kh * 8 + q * 4 + 0) * 256 + (tid & 255)] = a[q].x; ktab[(kh * 8 + q * 4 + 1) * 256 + (tid & 255)] = a[q].y;
            ktab[(kh * 8 + q * 4 + 2) * 256 + (tid & 255)] = a[q].z; ktab[(kh * 8 + q * 4 + 3) * 256 + (tid & 255)] = a[q].w; }
    }
    __syncthreads();
    for (int idx = tid; idx < 64 * (KI / 8); idx += NTHR) {
        const int nl = idx / (KI / 8), kc = idx % (KI / 8), t = tq * (QC / 4) + (nl >> 4), co = nl & 15, s = kc >> 1, ci0 = (kc & 1) * 8, lag = t - s;
        u32x4 o = {0u, 0u, 0u, 0u};
        if (lag >= 0) { const f32x4 k0 = *(const f32x4*)(ktab + lag * 256 + co * 16 + ci0), k1 = *(const f32x4*)(ktab + lag * 256 + co * 16 + ci0 + 4); o = pk8(k0, k1); }
        *(u32x4*)(M13 + (size_t)(t * 16 + co) * KA + kc * 8) = o;
    }
    for (int idx = tid; idx < 64 * 16; idx += NTHR) {
        const int nl = idx >> 4, pc = idx & 15, t = tq * (QC / 4) + (nl >> 4), co = nl & 15;
        float vv[8];
#pragma unroll
        for (int pp = 0; pp < 4; ++pp) { const int p = pc * 4 + pp; const float cr = ccr[co * 64 + p], ci = cci[co * 64 + p], wr = pwr[p * PS + t + 1], wi = pwi[p * PS + t + 1];
            vv[2 * pp] = cr * wr - ci * wi; vv[2 * pp + 1] = -(cr * wi + ci * wr); }
        u32x4 o; o.x = pk2(vv[0], vv[1]); o.y = pk2(vv[2], vv[3]); o.z = pk2(vv[4], vv[5]); o.w = pk2(vv[6], vv[7]);
        *(u32x4*)(M13 + (size_t)(t * 16 + co) * KA + KI + pc * 8) = o;
    }
    for (int idx = tid; idx < 32 * (KI / 8); idx += NTHR) {
        const int n2 = tq * 32 + idx / (KI / 8), kc = idx % (KI / 8), p = n2 >> 1, ri = n2 & 1, s = kc >> 1, ci0 = (kc & 1) * 8;
        const float wr = pwr[p * PS + (QC - 1) - s], wi = pwi[p * PS + (QC - 1) - s];
        float vv[8];
#pragma unroll
        for (int j = 0; j < 8; ++j) { const float br = bbr[p * 16 + ci0 + j], bi = bbi[p * 16 + ci0 + j]; vv[j] = ri ? (wr * bi + wi * br) : (wr * br - wi * bi); }
        u32x4 o; o.x = pk2(vv[0], vv[1]); o.y = pk2(vv[2], vv[3]); o.z = pk2(vv[4], vv[5]); o.w = pk2(vv[6], vv[7]);
        *(u32x4*)(M2 + (size_t)n2 * KI + kc * 8) = o;
    }
    if (tq == 0 && tid < 64) { float* aq = (float*)(P.ws + OFF_AQ) + (size_t)(lg * 64 + tid) * 2; aq[0] = pwr[tid * PS + QC]; aq[1] = pwi[tid * PS + QC]; }
    __syncthreads();
}
struct TItem { const float* src; bf16_t* dst; int K, N, k0, n0; };
__device__ __forceinline__ TItem decode_titem(const Params& P, int it) {
    constexpr int I_IN = 16 * 64, I_GLU = 64, I_POOL = 16, I_A = 128, I_B = 128, I_OUT = 256, I_L = I_IN + I_GLU + I_POOL + I_A + I_B + I_OUT;
    const int l = it / I_L; int r = it % I_L;
    unsigned char* wl = P.ws + OFF_W + (size_t)l * WL_SIZE;
    TItem t; int kb, nb;
    if (r < I_IN) { t.src = P.w_in + (size_t)l * 1024 * 4096; t.dst = (bf16_t*)(wl + WL_WIN); t.K = 1024; t.N = 4096; kb = r / 64; nb = r % 64; }
    else if ((r -= I_IN) < I_GLU) { t.src = P.w_glu + (size_t)l * 512 * 512; t.dst = (bf16_t*)(wl + WL_WGLU); t.K = 512; t.N = 512; kb = r / 8; nb = r % 8; }
    else if ((r -= I_GLU) < I_POOL) { const int pg = r >> 2; t.src = P.pool_w + (size_t)(l * 4 + pg) * 128 * 128; t.dst = (bf16_t*)(wl + WL_POOL) + pg * 128 * 128; t.K = 128; t.N = 128; kb = (r >> 1) & 1; nb = r & 1; }
    else if ((r -= I_POOL) < I_A) { t.src = P.w_a + (size_t)l * 512 * 1024; t.dst = (bf16_t*)(wl + WL_WA); t.K = 512; t.N = 1024; kb = r / 16; nb = r % 16; }
    else if ((r -= I_A) < I_B) { t.src = P.w_b + (size_t)l * 512 * 1024; t.dst = (bf16_t*)(wl + WL_WB); t.K = 512; t.N = 1024; kb = r / 16; nb = r % 16; }
    else { r -= I_B; t.src = P.w_out + (size_t)l * 1024 * 1024; t.dst = (bf16_t*)(wl + WL_WOUT); t.K = 1024; t.N = 1024; kb = r / 16; nb = r % 16; }
    t.k0 = kb * 64; t.n0 = nb * 64; return t;
}
__device__ __forceinline__ void phase_prologue(const Params& P, unsigned char* lds, int part, int wb, int nw) {
    const int tid = threadIdx.x, G = gridDim.x, half = tid >> 8, t2 = tid & 255;
    constexpr int N_TITEMS = 2 * (16 * 64 + 64 + 16 + 128 + 128 + 256);
    float* tile = (float*)lds + half * (2 * 64 * 65);
    for (int it0 = part * (N_TITEMS / 2) + wb * 4; it0 < (part + 1) * (N_TITEMS / 2); it0 += 4 * nw) {
        const TItem ta = decode_titem(P, it0 + half * 2), tb = decode_titem(P, it0 + half * 2 + 1);
        transpose_load(ta.src, ta.N, ta.k0, ta.n0, tile, t2);
        transpose_load(tb.src, tb.N, tb.k0, tb.n0, tile + 64 * 65, t2);
        __syncthreads();
        transpose_store(ta.dst, ta.K, ta.k0, ta.n0, tile, t2);
        transpose_store(tb.dst, tb.K, tb.k0, tb.n0, tile + 64 * 65, t2);
        __syncthreads();
    }
    for (int it = part * 128 + wb; it < (part + 1) * 128; it += nw) ssm_tables_item(P, it, lds);
    if (part != 0) return;
    float* ss = (float*)(P.ws + OFF_SS);
    for (int i = blockIdx.x * NTHR + tid; i < 2 * T; i += G * NTHR) ss[T + i] = 0.f;
    bf16_t* H = (bf16_t*)(P.ws + OFF_H);
    const int lane = tid & 63, wid = tid >> 6;
    for (int it = blockIdx.x; it < T / 8; it += 2 * G) {
        const int rowa = it * 8 + wid, rowb = (it + G < T / 8) ? (it + G) * 8 + wid : rowa;
        const float* xa = P.x + (size_t)rowa * DM; const float* xb2 = P.x + (size_t)rowb * DM;
        f32x4 va[4], vb[4], gg[4];
#pragma unroll
        for (int j = 0; j < 4; ++j) { const int c = lane * 4 + 256 * j; va[j] = *(const f32x4*)(xa + c); vb[j] = *(const f32x4*)(xb2 + c); gg[j] = *(const f32x4*)(P.norm_g + c); }
        float sa = 0.f, sb = 0.f;
#pragma unroll
        for (int j = 0; j < 4; ++j) { const int c = lane * 4 + 256 * j;
            sa += (va[j].x * va[j].x + va[j].y * va[j].y) + (va[j].z * va[j].z + va[j].w * va[j].w);
            sb += (vb[j].x * vb[j].x + vb[j].y * vb[j].y) + (vb[j].z * vb[j].z + vb[j].w * vb[j].w);
            *(u32x2*)(H + (size_t)rowa * DM + c) = pk4(va[j] * gg[j]);
            if (rowb != rowa) *(u32x2*)(H + (size_t)rowb * DM + c) = pk4(vb[j] * gg[j]); }
#pragma unroll
        for (int o = 1; o < 64; o <<= 1) { sa += __shfl_xor(sa, o); sb += __shfl_xor(sb, o); }
        if (lane == 0) { ss[rowa] = sa; if (rowb != rowa) ss[rowb] = sb; }
    }
}

typedef f32x4 Acc8[2][2][4][2];
#define PG_EPI_ROWS(...) _Pragma("unroll") for (int ai = 0; ai < 2; ++ai) _Pragma("unroll") for (int m = 0; m < 4; ++m) { const int row = u.pm * 256 + ai * 128 + wr * 64 + m * 16 + fr; __VA_ARGS__ }
#define PG_EPI_COLS(...) _Pragma("unroll") for (int bj = 0; bj < 2; ++bj) { const int col = u.pn * 256 + bj * 128 + wc * 32 + 8 * fq; const f32x4 v0 = acc[ai][bj][m][0], v1 = acc[ai][bj][m][1]; __VA_ARGS__ }
__device__ __forceinline__ f32x4 sigm4(f32x4 a) { f32x4 r; r.x = sigm(a.x); r.y = sigm(a.y); r.z = sigm(a.z); r.w = sigm(a.w); return r; }
__device__ __forceinline__ f32x4 silu4(f32x4 a) { return a * sigm4(a); }

#define ROW_OF(ai, m) (u.pm * 256 + (ai) * 128 + wr * 64 + (m) * 16 + fr)
#define COL_OF(bj) (u.pn * 256 + (bj) * 128 + wc * 32 + 8 * fq)
#define UNR _Pragma("unroll")
struct EpiProj { static constexpr bool PERM = true, AFTER_DRAIN = false;
    const float* ss; const float* bias; unsigned char* ws;
    __device__ __forceinline__ void operator()(const Acc8& acc, const pg8::Unit& u, int wr, int wc, int fr, int fq) const {
        const int pn = u.pn; bf16_t* dst; int ldd, cbase;
        if (pn < 2) { dst = (bf16_t*)(ws + OFF_UAP); ldd = 0; cbase = 0; }
        else if (pn < 4) { dst = (bf16_t*)(ws + OFF_ZA); ldd = 512; cbase = 512; }
        else if (pn < 6) { dst = (bf16_t*)(ws + OFF_UB); ldd = 512; cbase = 1024; }
        else if (pn < 8) { dst = (bf16_t*)(ws + OFF_ZB); ldd = 512; cbase = 1536; }
        else if (pn < 12) { dst = (bf16_t*)(ws + OFF_GA); ldd = 1024; cbase = 2048; }
        else { dst = (bf16_t*)(ws + OFF_GB); ldd = 1024; cbase = 3072; }
        f32x4 bv[2][2]; float inv[2][4];
        UNR for (int bj = 0; bj < 2; ++bj) { bv[bj][0] = *(const f32x4*)(bias + COL_OF(bj)); bv[bj][1] = *(const f32x4*)(bias + COL_OF(bj) + 4); }
        UNR for (int ai = 0; ai < 2; ++ai) UNR for (int m = 0; m < 4; ++m) inv[ai][m] = ss[ROW_OF(ai, m)];
        UNR for (int ai = 0; ai < 2; ++ai) UNR for (int m = 0; m < 4; ++m) inv[ai][m] = rsqrtf(inv[ai][m] * (1.f / DM) + EPS);
        UNR for (int ai = 0; ai < 2; ++ai) UNR for (int m = 0; m < 4; ++m) { const int row = ROW_OF(ai, m);
            UNR for (int bj = 0; bj < 2; ++bj) { const int col = COL_OF(bj);
                const u32x4 w = pk8(acc[ai][bj][m][0] * inv[ai][m] + bv[bj][0], acc[ai][bj][m][1] * inv[ai][m] + bv[bj][1]);
                if (pn < 2) *(u32x4*)(dst + ((size_t)((col >> 4) * MG + (row >> QSH)) * KA + (row & (QC - 1)) * 16 + (col & 15))) = w;
                else *(u32x4*)(dst + (size_t)row * ldd + (col - cbase)) = w; } }
    }
};
struct EpiGlu { static constexpr bool PERM = true, AFTER_DRAIN = false;
    const bf16_t* YP; const bf16_t* ZA; bf16_t* YA; const float* bg;
    __device__ __forceinline__ void operator()(const Acc8& acc, const pg8::Unit& u, int wr, int wc, int fr, int fq) const {
        f32x4 bv[2][2];
        UNR for (int bj = 0; bj < 2; ++bj) { bv[bj][0] = *(const f32x4*)(bg + COL_OF(bj)); bv[bj][1] = *(const f32x4*)(bg + COL_OF(bj) + 4); }
        UNR for (int ai = 0; ai < 2; ++ai) {
            u32x4 yv[4][2], zv[4][2];
            UNR for (int m = 0; m < 4; ++m) UNR for (int bj = 0; bj < 2; ++bj) { const size_t o = (size_t)ROW_OF(ai, m) * 512 + COL_OF(bj); yv[m][bj] = *(const u32x4*)(YP + o); zv[m][bj] = *(const u32x4*)(ZA + o); }
            UNR for (int m = 0; m < 4; ++m) UNR for (int bj = 0; bj < 2; ++bj) {
                f32x4 y0, y1, z0, z1; unpk8(yv[m][bj], y0, y1); unpk8(zv[m][bj], z0, z1);
                const f32x4 o0 = y0 * sigm4(acc[ai][bj][m][0] + bv[bj][0]) * silu4(z0), o1 = y1 * sigm4(acc[ai][bj][m][1] + bv[bj][1]) * silu4(z1);
                *(u32x4*)(YA + (size_t)ROW_OF(ai, m) * 512 + COL_OF(bj)) = pk8(o0, o1); }
        }
    }
};
template <int PASS> struct EpiMerge { static constexpr bool PERM = true, AFTER_DRAIN = false;
    bf16_t* GA; const bf16_t* GB;
    __device__ __forceinline__ void operator()(const Acc8& acc, const pg8::Unit& u, int wr, int wc, int fr, int fq) const {
        UNR for (int ai = 0; ai < 2; ++ai) {
            u32x4 av[4][2], bv[4][2];
            UNR for (int m = 0; m < 4; ++m) UNR for (int bj = 0; bj < 2; ++bj) { const size_t o = (size_t)ROW_OF(ai, m) * DM + COL_OF(bj); av[m][bj] = *(const u32x4*)(GA + o); if (PASS == 1) bv[m][bj] = *(const u32x4*)(GB + o); }
            UNR for (int m = 0; m < 4; ++m) UNR for (int bj = 0; bj < 2; ++bj) {
                f32x4 a0, a1, o0, o1; unpk8(av[m][bj], a0, a1);
                if (PASS == 0) { o0 = sigm4(a0) * acc[ai][bj][m][0]; o1 = sigm4(a1) * acc[ai][bj][m][1]; }
                else { f32x4 b0, b1; unpk8(bv[m][bj], b0, b1); o0 = a0 + sigm4(b0) * acc[ai][bj][m][0]; o1 = a1 + sigm4(b1) * acc[ai][bj][m][1]; }
                *(u32x4*)(GA + (size_t)ROW_OF(ai, m) * DM + COL_OF(bj)) = pk8(o0, o1); }
        }
    }
};
template <int L> struct EpiOut { static constexpr bool PERM = true, AFTER_DRAIN = false;
    const float* xin; float* xout; float* ssn; bf16_t* H; const float* gn;
    __device__ __forceinline__ void operator()(const Acc8& acc, const pg8::Unit& u, int wr, int wc, int fr, int fq) const {
        f32x4 gv[2][2];
        if (L == 0) { UNR for (int bj = 0; bj < 2; ++bj) { gv[bj][0] = *(const f32x4*)(gn + COL_OF(bj)); gv[bj][1] = *(const f32x4*)(gn + COL_OF(bj) + 4); } }
        UNR for (int ai = 0; ai < 2; ++ai) UNR for (int mh = 0; mh < 2; ++mh) {
            f32x4 xv[2][2][2];
            UNR for (int mm = 0; mm < 2; ++mm) UNR for (int bj = 0; bj < 2; ++bj) { const float* p = xin + (size_t)ROW_OF(ai, mh * 2 + mm) * DM + COL_OF(bj); xv[mm][bj][0] = *(const f32x4*)p; xv[mm][bj][1] = *(const f32x4*)(p + 4); }
            UNR for (int mm = 0; mm < 2; ++mm) { const int m = mh * 2 + mm; const int row = ROW_OF(ai, m); float s = 0.f;
                UNR for (int bj = 0; bj < 2; ++bj) { const int col = COL_OF(bj);
                    const f32x4 o0 = xv[mm][bj][0] + acc[ai][bj][m][0], o1 = xv[mm][bj][1] + acc[ai][bj][m][1];
                    *(f32x4*)(xout + (size_t)row * DM + col) = o0; *(f32x4*)(xout + (size_t)row * DM + col + 4) = o1;
                    s += ((o0.x * o0.x + o0.y * o0.y) + (o0.z * o0.z + o0.w * o0.w)) + ((o1.x * o1.x + o1.y * o1.y) + (o1.z * o1.z + o1.w * o1.w));
                    if (L == 0) *(u32x4*)(H + (size_t)row * DM + col) = pk8(o0 * gv[bj][0], o1 * gv[bj][1]); }
                s += __shfl_xor(s, 16); s += __shfl_xor(s, 32);
                if (fq == 0) atomicAdd(ssn + row, s); }
        }
    }
};
struct EpiOutFinal { static constexpr bool PERM = true, AFTER_DRAIN = true;
    const float* xin; float* out; float* ssn; const float* fg; XcdBarrier xb; unsigned* grp; bool local;
    __device__ __forceinline__ void fused(Acc8& acc, const pg8::Unit& u, int wr, int wc, int fr, int fq, PG8_LAS unsigned char*, int, int) const {
        UNR for (int ai = 0; ai < 2; ++ai) {
            f32x4 xv[4][2][2];
            UNR for (int m = 0; m < 4; ++m) UNR for (int bj = 0; bj < 2; ++bj) { const float* p = xin + (size_t)ROW_OF(ai, m) * DM + COL_OF(bj); xv[m][bj][0] = *(const f32x4*)p; xv[m][bj][1] = *(const f32x4*)(p + 4); }
            UNR for (int m = 0; m < 4; ++m) { float s = 0.f;
                UNR for (int bj = 0; bj < 2; ++bj) {
                    const f32x4 o0 = xv[m][bj][0] + acc[ai][bj][m][0], o1 = xv[m][bj][1] + acc[ai][bj][m][1];
                    acc[ai][bj][m][0] = o0; acc[ai][bj][m][1] = o1;
                    s += ((o0.x * o0.x + o0.y * o0.y) + (o0.z * o0.z + o0.w * o0.w)) + ((o1.x * o1.x + o1.y * o1.y) + (o1.z * o1.z + o1.w * o1.w)); }
                s += __shfl_xor(s, 16); s += __shfl_xor(s, 32);
                if (fq == 0) atomicAdd(ssn + ROW_OF(ai, m), s); }
        }
        seam_sync(xb, grp, local);
        f32x4 gv[2][2]; float inv[2][4];
        UNR for (int bj = 0; bj < 2; ++bj) { gv[bj][0] = *(const f32x4*)(fg + COL_OF(bj)); gv[bj][1] = *(const f32x4*)(fg + COL_OF(bj) + 4); }
        UNR for (int ai = 0; ai < 2; ++ai) UNR for (int m = 0; m < 4; ++m) inv[ai][m] = __hip_atomic_load(ssn + ROW_OF(ai, m), __ATOMIC_RELAXED, __HIP_MEMORY_SCOPE_AGENT);
        UNR for (int ai = 0; ai < 2; ++ai) UNR for (int m = 0; m < 4; ++m) inv[ai][m] = rsqrtf(inv[ai][m] * (1.f / DM) + EPS);
        UNR for (int ai = 0; ai < 2; ++ai) UNR for (int m = 0; m < 4; ++m) UNR for (int bj = 0; bj < 2; ++bj) { float* p = out + (size_t)ROW_OF(ai, m) * DM + COL_OF(bj);
            *(f32x4*)p = (acc[ai][bj][m][0] * inv[ai][m]) * gv[bj][0]; *(f32x4*)(p + 4) = (acc[ai][bj][m][1] * inv[ai][m]) * gv[bj][1]; }
    }
};

template <class Epi>
__device__ __forceinline__ void big_gemm(unsigned char* lds, const bf16_t* A, const bf16_t* Bt, int N, int K, const Epi& E, int c) {
    pg8::Gemm g{A, Bt, T, N, K}; pg8::StaticOrder S; S.init(T, N, (int)gridDim.x, c);
    pg8::gemm_phase<Epi, pg8::StaticOrder, true, true>((PG8_LAS unsigned char*)lds, g, S, E);
}
__device__ __forceinline__ void phase_proj(const Params& P, int l, unsigned char* lds, int c) {
    const unsigned char* wl = P.ws + OFF_W + (size_t)l * WL_SIZE;
    EpiProj E{(const float*)(P.ws + OFF_SS) + (size_t)l * T, P.b_in + (size_t)l * 4096, P.ws};
    big_gemm(lds, (const bf16_t*)(P.ws + OFF_H), (const bf16_t*)(wl + WL_WIN), 4096, 1024, E, c);
}
__device__ __forceinline__ void phase_s5(const Params& P, int l, unsigned char* lds0, int c, bool local) {
    const unsigned char* wl = P.ws + OFF_W + (size_t)l * WL_SIZE;
    const int half = threadIdx.x >> 8; unsigned char* lds = lds0 + half * HALF_LDS;
    const float* dsk = P.d_skip + (size_t)l * 512; bf16_t* YP = (bf16_t*)(P.ws + OFF_YPRE);
    for (int tp = c; tp < 256; tp += gridDim.x) {
        int nt, g, mt;
        if (local) { const int x = tp & 7, j = tp >> 3; mt = x; nt = 1 - (j >> 4); g = (j & 15) * 2 + half; }
        else if (gridDim.x == 256) { const int x = tp & 7, j = tp >> 3, r = j & 7; g = x * 4 + (j >> 3); nt = r >> 2; mt = (r & 3) * 2 + half; }
        else { const int t = tp * 2 + half; nt = 1 - (t >> 8); g = (t >> 3) & 31; mt = t & 7; }
        bf16_t* U = (bf16_t*)(P.ws + OFF_UAP) + (size_t)(g * MG + mt * 128) * KA;
        f32x4 acc[4][4]; zero_acc(acc);
        gemm_mainloop(acc, LoadPlain{U, KA}, LoadPlain{(const bf16_t*)(wl + WL_M2) + (size_t)g * 128 * KI, KI}, KTI, lds);
        float* Sl = (float*)lds;
        EPI_LOOP( *(f32x4*)(Sl + m * 132 + n) = v; );
        __syncthreads();
        {
            int tid = threadIdx.x & 255; asm volatile("" : "+v"(tid));
            if (tid < 64) {
                const int p = tid;
                const float* aq = (const float*)(P.ws + OFF_AQ) + (size_t)((l * 32 + g) * 64 + p) * 2;
                const float ar = aq[0], ai = aq[1];
                float xr = 0.f, xi = 0.f;
#pragma unroll 8
                for (int c2 = 0; c2 < 128; ++c2) {
                    *(unsigned*)(U + (size_t)c2 * KA + KI + 2 * p) = pk2(xr, xi);
                    const float sr = Sl[c2 * 132 + 2 * p], si = Sl[c2 * 132 + 2 * p + 1];
                    const float nr = ar * xr - ai * xi + sr; xi = ar * xi + ai * xr + si; xr = nr;
                }
            }
            asm volatile("s_waitcnt vmcnt(0)" ::: "memory");
        }
        __syncthreads();
        const int nk1 = (nt + 1) * 2;
        zero_acc(acc);
        gemm_mainloop(acc, LoadRemap{U, KA, nk1}, LoadRemap{(const bf16_t*)(wl + WL_M13) + (size_t)(g * KI + nt * 128) * KA, KA, nk1}, nk1 + 2, lds);
        u32x2 uu[4][4]; f32x4 d4 = {0.f, 0.f, 0.f, 0.f};
        EPI_LOOP( uu[i][j] = *(const u32x2*)(U + (size_t)m * KA + nt * 128 + n); if (i == 0 && j == 0) d4 = *(const f32x4*)(dsk + g * 16 + (n & 15)); );
        EPI_LOOP(
            const int mm = mt * 128 + m, nn = nt * 128 + n, ch = g * 16 + (nn & 15);
            const f32x4 u = unpk4(uu[i][j]);
            f32x4 o; o.x = gelu_tanh(v.x + d4.x * u.x); o.y = gelu_tanh(v.y + d4.y * u.y); o.z = gelu_tanh(v.z + d4.z * u.z); o.w = gelu_tanh(v.w + d4.w * u.w);
            *(u32x2*)(YP + (size_t)(mm * QC + (nn >> 4)) * 512 + ch) = pk4(o);
        );
    }
}
__device__ __forceinline__ void pool_pairs(const Params& P, int l, unsigned char* lds0, int first, int end, int stride) {
    const unsigned char* wl = P.ws + OFF_W + (size_t)l * WL_SIZE;
    const int half = threadIdx.x >> 8; unsigned char* lds = lds0 + half * HALF_LDS;
    const bf16_t* ZB = (const bf16_t*)(P.ws + OFF_ZB); bf16_t* YB = (bf16_t*)(P.ws + OFF_YB); const float* sc = P.pool_scale + (size_t)l * 512;
    for (int tp = first; tp < end; tp += stride) {
        const int u = tp * 2 + half, pg = u & 3, mt = u >> 2;
        f32x4 acc[4][4]; zero_acc(acc);
        u32x2 zz[4][4]; f32x4 s4[4];
        {   int _t = threadIdx.x & 255; asm volatile("" : "+v"(_t));
#pragma unroll
            for (int j = 0; j < 4; ++j) s4[j] = *(const f32x4*)(sc + pg * 128 + ((_t >> 6) & 1) * 64 + j * 16 + ((_t & 63) >> 4) * 4); }
        pool_tile(acc, (const bf16_t*)(P.ws + OFF_UB), (const bf16_t*)(wl + WL_POOL) + (size_t)pg * 128 * 128, ZB, zz, mt * 128, pg, lds);
        EPI_LOOP(
            const int row = mt * 128 + m, col = pg * 128 + n;
            *(u32x2*)(YB + (size_t)row * 512 + col) = pk4(v * s4[j] * silu4(unpk4(zz[i][j])));
        );
    }
}
__device__ __forceinline__ void phase_glu(const Params& P, int l, unsigned char* lds, int c, bool local) {
    const unsigned char* wl = P.ws + OFF_W + (size_t)l * WL_SIZE;
    EpiGlu E{(const bf16_t*)(P.ws + OFF_YPRE), (const bf16_t*)(P.ws + OFF_ZA), (bf16_t*)(P.ws + OFF_YA), P.b_glu + (size_t)l * 512};
    big_gemm(lds, (const bf16_t*)(P.ws + OFF_YPRE), (const bf16_t*)(wl + WL_WGLU), 512, 512, E, c);
    const int G = (int)gridDim.x;
    if (local) { if (c >= 128) { const int pm = (c & 7) * 8 + ((c >> 3) & 7), mt = 2 * pm + (((c >> 3) - 16) >> 3); pool_pairs(P, l, lds, 2 * mt, 2 * mt + 2, 1); } }
    else if (G > 128) { if (c >= 128) pool_pairs(P, l, lds, c - 128, 256, G - 128); }
    else pool_pairs(P, l, lds, c, 256, G);
}
__device__ __forceinline__ void phase_merge(const Params& P, int l, unsigned char* lds, int c) {
    const unsigned char* wl = P.ws + OFF_W + (size_t)l * WL_SIZE;
#ifdef PROBE_M
    for (int rep = 0; rep < 2; ++rep) {
    EpiMerge<0> E0{rep == 0 ? (bf16_t*)(P.ws + OFF_UB) : (bf16_t*)(P.ws + OFF_GA), (const bf16_t*)(P.ws + OFF_GB)};
    big_gemm(lds, (const bf16_t*)(P.ws + OFF_YA), (const bf16_t*)(wl + WL_WA), 1024, 512, E0, c);
    }
#else
    EpiMerge<0> E0{(bf16_t*)(P.ws + OFF_GA), (const bf16_t*)(P.ws + OFF_GB)};
    big_gemm(lds, (const bf16_t*)(P.ws + OFF_YA), (const bf16_t*)(wl + WL_WA), 1024, 512, E0, c);
#endif
    EpiMerge<1> E1{(bf16_t*)(P.ws + OFF_GA), (const bf16_t*)(P.ws + OFF_GB)};
    big_gemm(lds, (const bf16_t*)(P.ws + OFF_YB), (const bf16_t*)(wl + WL_WB), 1024, 512, E1, c);
}
template <int L>
__device__ __forceinline__ void phase_out(const Params& P, unsigned char* lds, int c) {
    const unsigned char* wl = P.ws + OFF_W + (size_t)L * WL_SIZE;
#ifdef PROBE_O
    for (int rep = 0; rep < (L == 0 ? 2 : 1); ++rep) {
    EpiOut<L> E{L == 0 ? P.x : P.out, P.out, (L == 0 && rep == 0) ? (float*)(P.ws + OFF_S) : (float*)(P.ws + OFF_SS) + (size_t)(L + 1) * T, (bf16_t*)(P.ws + OFF_H), P.norm_g + (size_t)(L == 0 ? 1 : 0) * DM};
    big_gemm(lds, (const bf16_t*)(P.ws + OFF_GA), (const bf16_t*)(wl + WL_WOUT), 1024, 1024, E, c);
    }
#else
    EpiOut<L> E{L == 0 ? P.x : P.out, P.out, (float*)(P.ws + OFF_SS) + (size_t)(L + 1) * T, (bf16_t*)(P.ws + OFF_H), P.norm_g + (size_t)(L == 0 ? 1 : 0) * DM};
    big_gemm(lds, (const bf16_t*)(P.ws + OFF_GA), (const bf16_t*)(wl + WL_WOUT), 1024, 1024, E, c);
#endif
}
__device__ __forceinline__ void phase_out_final(const Params& P, unsigned char* lds, const XcdBarrier& xb, unsigned* grp, bool local, int c) {
    const unsigned char* wl = P.ws + OFF_W + (size_t)1 * WL_SIZE;
    EpiOutFinal E{P.out, P.out, (float*)(P.ws + OFF_SS) + (size_t)2 * T, P.final_g, xb, grp, local};
    pg8::Gemm g{(const bf16_t*)(P.ws + OFF_GA), (const bf16_t*)(wl + WL_WOUT), T, 1024, 1024}; pg8::StaticOrder S; S.init(T, 1024, (int)gridDim.x, c);
    pg8::gemm_phase<EpiOutFinal, pg8::StaticOrder, false, true>((PG8_LAS unsigned char*)lds, g, S, E);
}
__device__ __forceinline__ void phase_final(const Params& P) {
    const float* ss = (const float*)(P.ws + OFF_SS) + 2 * (size_t)T;
    for (int i = blockIdx.x * NTHR + threadIdx.x; i < T * (DM / 4); i += gridDim.x * NTHR) {
        const int row = i >> 8, c = (i & 255) * 4;
        const float inv = rsqrtf(ss[row] * (1.f / DM) + EPS);
        f32x4* p = (f32x4*)(P.out + (size_t)row * DM + c);
        *p = (*p * inv) * *(const f32x4*)(P.final_g + c);
    }
}

constexpr int N_PHASES = 12;
__global__ void __launch_bounds__(512, 2) hawk_fwd(Params P) {
    extern __shared__ __attribute__((aligned(16))) unsigned char lds[];
    volatile LAS unsigned* st = (volatile LAS unsigned*)(LAS unsigned char*)(lds + LDS_XB);
    const int lo = P.ph_lo, hi = P.ph_hi;
    XcdBarrier xb; xb.bar = (unsigned*)(P.ws + OFF_BAR); xb.x = 0; xb.st = st;
    if (hi - lo > 1) {
        if (threadIdx.x == 0) { st[0] = 0u; st[1] = 0u; st[2] = 0u; st[3] = 0u; st[4] = 0u; }
        __syncthreads();
        xb = xcd_barrier_post((unsigned*)(P.ws + OFF_BAR), st);
    }
#ifndef PROBE_DUP
#define PROBE_DUP -1
#endif
#define PH(k, ...) if (lo <= (k) && (k) < hi) { if ((k) > lo) xcd_barrier(xb); __VA_ARGS__; if (PROBE_DUP == (k)) { xcd_barrier(xb); __VA_ARGS__; } }
    const bool fuse_final = (gridDim.x == 256) && (lo == 0) && (hi == N_PHASES);
    PH(0, phase_prologue(P, lds, 0, (int)blockIdx.x, (int)gridDim.x))
    if (lo == 0 && hi == 1) phase_prologue(P, lds, 1, (int)blockIdx.x, (int)gridDim.x);
    int c = (int)blockIdx.x; bool even = false;
    if (lo == 0 && hi > 1) {
        xcd_barrier(xb);
        even = (gridDim.x % 8u) == 0u;
#pragma unroll
        for (unsigned j = 0; j < 16; ++j) { const unsigned n = xb_ld(&xb.bar[XB_XCNT(j)]); even = even && (n == (j < 8 ? gridDim.x / 8u : 0u)); }
        if (even) c = (int)(st[2] * 8u + xb.x);
    }
    const bool local = fuse_final && even;
    unsigned* grp = xb.bar + 4096 + 64 * ((c & 7) * 8 + ((c >> 3) & 7));
#undef PH
#define PH(k, ...) if (lo <= (k) && (k) < hi) { if ((k) > lo && (k) > 1) xcd_barrier(xb); __VA_ARGS__; if (PROBE_DUP == (k)) { xcd_barrier(xb); __VA_ARGS__; } }
#define PHS(k, ...) if (lo <= (k) && (k) < hi) { if ((k) > lo) seam_sync(xb, grp, local); __VA_ARGS__; }
#define PHX(k, ...) if (lo <= (k) && (k) < hi) { if ((k) > lo && (k) > 1) seam_sync_xcc(xb, xcnt, local); __VA_ARGS__; if (PROBE_DUP == (k)) { seam_sync_xcc(xb, xcnt, local); __VA_ARGS__; } }
    unsigned* xcnt = xb.bar + 3520 + 64 * (c & 7);
    unsigned* l1flag = xb.bar + 4032;
    if (lo == 0 && hi > 1) {
        if (local) {
            if ((c & 1) == 0) {
                phase_prologue(P, lds, 1, (c >> 3) * 4 + ((c & 7) >> 1), 128);
                asm volatile("s_waitcnt vmcnt(0)" ::: "memory");
                __syncthreads();
                if (threadIdx.x == 0) { __builtin_amdgcn_fence(__ATOMIC_RELEASE, "agent"); asm volatile("s_waitcnt vmcnt(0)" ::: "memory"); (void)xb_add(l1flag, 1u); }
            }
        } else { phase_prologue(P, lds, 1, (int)blockIdx.x, (int)gridDim.x); xcd_barrier(xb); }
    }
    PH(1, phase_proj(P, 0, lds, c))
    PHX(2, phase_s5(P, 0, lds, c, local))
    if (local && c >= 128) { group_arrive(xb, xcnt, 4); phase_glu(P, 0, lds, c, local); } else {
    PHX(3, phase_glu(P, 0, lds, c, local))
    }
    PHS(4, phase_merge(P, 0, lds, c))
    PHS(5, phase_out<0>(P, lds, c))
    if (local) { if (threadIdx.x == 0) { XB_SPIN(xb_ld(l1flag) < 128u, xb.bar); } __syncthreads(); }
    PHX(6, phase_proj(P, 1, lds, c))
    PHX(7, phase_s5(P, 1, lds, c, local))
    if (local && c >= 128) { group_arrive(xb, xcnt, 4); phase_glu(P, 1, lds, c, local); } else {
    PHX(8, phase_glu(P, 1, lds, c, local))
    }
    PHS(9, phase_merge(P, 1, lds, c))
    if (fuse_final) { seam_sync(xb, grp, local); phase_out_final(P, lds, xb, grp, local, c); }
    else {
    PH(10, phase_out<1>(P, lds, c))
    PH(11, phase_final(P))
    }
#undef PHX
#undef PHS
#undef PH
}

extern "C" void kernel_launch(void* const* d_in, const int* in_sizes, int n_in, void* d_out, int out_size, void* d_ws, size_t ws_size, hipStream_t stream) {
    static int grid = 0;
    if (grid == 0) {
        if (n_in != 20 || in_sizes[0] != T * DM || out_size != T * DM || ws_size < WS_END) { fprintf(stderr, "kernel_launch: unexpected shapes / workspace (%zu needed, %zu given)\n", (size_t)WS_END, ws_size); grid = -1; return; }
        int dev = 0, cus = 0, per_cu = 0;
        if (hipGetDevice(&dev) != hipSuccess || hipDeviceGetAttribute(&cus, hipDeviceAttributeMultiprocessorCount, dev) != hipSuccess) { grid = -1; return; }
        if (hipFuncSetAttribute((const void*)hawk_fwd, hipFuncAttributeMaxDynamicSharedMemorySize, LDS_BYTES) != hipSuccess) { fprintf(stderr, "kernel_launch: hipFuncSetAttribute failed\n"); grid = -1; return; }
        if (hipOccupancyMaxActiveBlocksPerMultiprocessor(&per_cu, (const void*)hawk_fwd, NTHR, LDS_BYTES) != hipSuccess || per_cu < 1) { fprintf(stderr, "kernel_launch: occupancy query reports %d\n", per_cu); (void)hipGetLastError(); }
        grid = cus;
    }
    if (grid < 0) return;
    (void)hipMemsetAsync((unsigned char*)d_ws + OFF_BAR, 0, 32768, stream);
    Params p{};
    const float** pp = (const float**)&p;
    for (int i = 0; i < 20; ++i) pp[i] = (const float*)d_in[i];
    p.out = (float*)d_out; p.ws = (unsigned char*)d_ws;
#if N_LAUNCH_MODE == 1
    p.ph_lo = 0; p.ph_hi = N_PHASES;
    hipLaunchKernelGGL(hawk_fwd, dim3(grid), dim3(NTHR), LDS_BYTES, stream, p);
#else
    for (int ph = 0; ph < N_PHASES; ++ph) { p.ph_lo = ph; p.ph_hi = ph + 1; hipLaunchKernelGGL(hawk_fwd, dim3(grid), dim3(NTHR), LDS_BYTES, stream, p); }
#endif
}
```
